# Optimizing an MI355X kernel written in HIP

```python
import math
import jax, jax.numpy as jnp
from jax import lax
import numpy as np

D_MODEL = 2048
BATCH = 1
SEQ = 16384
DEPTH = 1

GRID_W = 64
CTX_LEN = 256
A_HEADS = 8
A_QK_DIM = 64
A_V_DIM = 2 * A_QK_DIM
ROPE_THETA = 10000.0
B_HEADS = 8
B_HEAD_DIM = 128
NA_KH = 8
NA_KW = 16
A_WIDTH = A_HEADS * A_V_DIM
B_WIDTH = B_HEADS * B_HEAD_DIM
IN_SIZES = (A_HEADS * 2 * A_QK_DIM, A_HEADS * 2 * A_QK_DIM, A_WIDTH,
            B_WIDTH, B_WIDTH, B_WIDTH, D_MODEL, D_MODEL)
N_IN = sum(IN_SIZES)
PEER_HEADS = 8
PEER_NKEYS = 128
PEER_N = PEER_NKEYS * PEER_NKEYS
PEER_TOPK = 16
PEER_QDIM = 256
PEER_CHUNK = 128
Q_BLOCK = 128
EPS = 1e-6

kernel_name = "hybrid_diffattn_natten_peer_dit_block"


def rmsnorm(x, g):
    xf = x.astype(jnp.float32)
    y = xf * lax.rsqrt(jnp.mean(xf * xf, axis=-1, keepdims=True) + EPS)
    return (y * g.astype(jnp.float32)).astype(x.dtype)


def ada_params(cond, w, b):
    m = jax.nn.silu(cond) @ w + b
    return [t[:, None, :] for t in jnp.split(m, 6, axis=-1)]


def modulate(x, g, shift, scale):
    return rmsnorm(x, g) * (1 + scale) + shift


def split_proj(p):
    B, T, _ = p.shape
    offs = [int(o) for o in np.cumsum(IN_SIZES)[:-1]]
    qa, ka, va, qb, kb, vb, ga, gb = jnp.split(p, offs, axis=-1)
    qa = qa.reshape(B, T, A_HEADS, 2, A_QK_DIM)
    ka = ka.reshape(B, T, A_HEADS, 2, A_QK_DIM)
    va = va.reshape(B, T, A_HEADS, A_V_DIM)
    qb = qb.reshape(B, T, B_HEADS, B_HEAD_DIM)
    kb = kb.reshape(B, T, B_HEADS, B_HEAD_DIM)
    vb = vb.reshape(B, T, B_HEADS, B_HEAD_DIM)
    return qa, ka, va, qb, kb, vb, ga, gb


def axial_rope_tables(seq_len, dtype):
    t = jnp.arange(seq_len)
    row = (t // GRID_W).astype(jnp.float32)
    col = (t % GRID_W).astype(jnp.float32)
    n_freq = A_QK_DIM // 4
    freqs = ROPE_THETA ** (-jnp.arange(n_freq, dtype=jnp.float32) / n_freq)
    ar = row[:, None] * freqs[None, :]
    ac = col[:, None] * freqs[None, :]
    ang = jnp.concatenate([ar, ar, ac, ac], axis=-1)
    return jnp.cos(ang).astype(dtype), jnp.sin(ang).astype(dtype)


def rotate_half_axial(x):
    xr = x.reshape(x.shape[:-1] + (2, 2, A_QK_DIM // 4))
    xr = jnp.stack([-xr[..., 1, :], xr[..., 0, :]], axis=-2)
    return xr.reshape(x.shape)


def apply_rope(x, cos, sin):
    c = cos[None, :, None, None, :]
    s = sin[None, :, None, None, :]
    return x * c + rotate_half_axial(x) * s


def diff_attention(q, k, v, lam, lam_init, g):
    B, T, H, _, d = q.shape
    nb = T // Q_BLOCK
    scale = d ** -0.5
    qb = q.reshape(B, nb, Q_BLOCK, H, 2, d).swapaxes(0, 1)

    def block(qblk):
        s = jnp.einsum('bqhid,bkhid->ibhqk', qblk, k).astype(jnp.float32) * scale
        p = jax.nn.softmax(s, axis=-1)
        a = p[0] - lam * p[1]
        return jnp.einsum('bhqk,bkhe->bqhe', a.astype(v.dtype), v)

    o = lax.map(block, qb)
    o = o.swapaxes(0, 1).reshape(B, T, H, v.shape[-1])
    o = rmsnorm(o, g) * (1.0 - lam_init)
    return o.reshape(B, T, H * v.shape[-1])


def neighbourhood_attention(q, k, v, kc, vc, rpb):
    B, T, H, d = q.shape
    rows = T // GRID_W
    kh = min(NA_KH, rows)
    kw = NA_KW
    scale = d ** -0.5
    qg = q.reshape(B, rows, GRID_W, H, d)
    kg = k.reshape(B, rows, GRID_W, H, d)
    vg = v.reshape(B, rows, GRID_W, H, d)
    cols = jnp.arange(GRID_W)
    col_start = jnp.clip(cols - kw // 2, 0, GRID_W - kw)
    col_idx = col_start[:, None] + jnp.arange(kw)[None, :]
    bias_c = rpb[:, :, col_idx - cols[:, None] + (NA_KW - 1)]

    def row(r):
        rs = jnp.clip(r - kh // 2, 0, rows - kh)
        dr = rs + jnp.arange(kh) - r
        bias = bias_c[:, dr + (NA_KH - 1)].transpose(0, 2, 1, 3)
        q_r = lax.dynamic_index_in_dim(qg, r, axis=1, keepdims=False)
        k_win = lax.dynamic_slice_in_dim(kg, rs, kh, axis=1)[:, :, col_idx]
        v_win = lax.dynamic_slice_in_dim(vg, rs, kh, axis=1)[:, :, col_idx]
        s_win = jnp.einsum('bqhd,biqjhd->bhqij', q_r, k_win).astype(jnp.float32) * scale
        s_win = s_win + bias[None].astype(jnp.float32)
        s_ctx = jnp.einsum('bqhd,bchd->bhqc', q_r, kc).astype(jnp.float32) * scale
        s = jnp.concatenate([s_win.reshape(B, H, GRID_W, kh * kw), s_ctx], axis=-1)
        p = jax.nn.softmax(s, axis=-1).astype(v.dtype)
        p_win = p[..., :kh * kw].reshape(B, H, GRID_W, kh, kw)
        p_ctx = p[..., kh * kw:]
        return (jnp.einsum('bhqij,biqjhd->bqhd', p_win, v_win)
                + jnp.einsum('bhqc,bchd->bqhd', p_ctx, vc))

    o = lax.map(row, jnp.arange(rows))
    return o.transpose(1, 0, 2, 3, 4).reshape(B, T, H * d)


def full_attention(q, k, v):
    B, T, H, d = q.shape
    s = jnp.einsum('bqhd,bkhd->bhqk', q, k).astype(jnp.float32) * (d ** -0.5)
    p = jax.nn.softmax(s, axis=-1).astype(v.dtype)
    return jnp.einsum('bhqk,bkhd->bqhd', p, v).reshape(B, T, H * d)


def merge(out_a, out_b, ga, gb, w_a, w_b, w_o):
    return (jax.nn.sigmoid(ga) * (out_a @ w_a) + jax.nn.sigmoid(gb) * (out_b @ w_b)) @ w_o


def peer(h, w_q, subkeys, u, v):
    B, T, D = h.shape
    n = B * T
    tok = h.reshape(n, D)
    q = (tok @ w_q).reshape(n, PEER_HEADS, 2, PEER_QDIM // 2)
    s = jnp.einsum('nhpd,hpkd->nhpk', q, subkeys).astype(jnp.float32)
    s1, i1 = lax.top_k(s[:, :, 0], PEER_TOPK)
    s2, i2 = lax.top_k(s[:, :, 1], PEER_TOPK)
    cand = (s1[..., :, None] + s2[..., None, :]).reshape(n, PEER_HEADS, PEER_TOPK * PEER_TOPK)
    cidx = (i1[..., :, None] * PEER_NKEYS + i2[..., None, :]).reshape(n, PEER_HEADS, PEER_TOPK * PEER_TOPK)
    best, pos = lax.top_k(cand, PEER_TOPK)
    idx = jnp.take_along_axis(cidx, pos, axis=-1)
    gates = jax.nn.softmax(best, axis=-1).astype(h.dtype)
    nc = n // PEER_CHUNK

    def chunk(args):
        t, ix, gg = args
        act = jax.nn.gelu(jnp.einsum('nd,nhkd->nhk', t, u[ix]))
        return jnp.einsum('nhk,nhkd->nd', gg * act, v[ix])

    out = lax.map(chunk, (tok.reshape(nc, PEER_CHUNK, D),
                          idx.reshape(nc, PEER_CHUNK, PEER_HEADS, PEER_TOPK),
                          gates.reshape(nc, PEER_CHUNK, PEER_HEADS, PEER_TOPK)))
    return out.reshape(B, T, D)


def setup_inputs(seed: int = 0) -> dict:
    key = jax.random.key(seed)
    ks = jax.random.split(key, 24)
    D = D_MODEL

    def nrm(k, shape, s):
        return jax.random.normal(k, shape, jnp.float32) * s

    return {
        'x': nrm(ks[0], (BATCH, SEQ, D), 1.0),
        'c': nrm(ks[1], (BATCH, D), 1.0),
        'ctx': nrm(ks[2], (BATCH, CTX_LEN, D), 1.0),
        'c_ctx': nrm(ks[3], (D,), 1.0),
        'w_mod': nrm(ks[4], (DEPTH, D, 6 * D), 0.5 * D ** -0.5),
        'b_mod': nrm(ks[5], (DEPTH, 6 * D), 0.01),
        'norm1_g': 1.0 + nrm(ks[6], (DEPTH, D), 0.02),
        'norm2_g': 1.0 + nrm(ks[7], (DEPTH, D), 0.02),
        'w_in': nrm(ks[8], (DEPTH, D, N_IN), D ** -0.5),
        'lambda_q1': nrm(ks[9], (DEPTH, A_QK_DIM), 0.1),
        'lambda_k1': nrm(ks[10], (DEPTH, A_QK_DIM), 0.1),
        'lambda_q2': nrm(ks[11], (DEPTH, A_QK_DIM), 0.1),
        'lambda_k2': nrm(ks[12], (DEPTH, A_QK_DIM), 0.1),
        'subln_g': 1.0 + nrm(ks[13], (DEPTH, A_V_DIM), 0.02),
        'na_rpb': nrm(ks[14], (DEPTH, B_HEADS, 2 * NA_KH - 1, 2 * NA_KW - 1), 0.1),
        'w_branch_a': nrm(ks[15], (DEPTH, A_WIDTH, D), A_WIDTH ** -0.5),
        'w_branch_b': nrm(ks[16], (DEPTH, B_WIDTH, D), B_WIDTH ** -0.5),
        'w_out': nrm(ks[17], (DEPTH, D, D), D ** -0.5),
        'peer_w_q': nrm(ks[18], (DEPTH, D, PEER_HEADS * PEER_QDIM), D ** -0.5),
        'peer_subkeys': nrm(ks[19], (DEPTH, PEER_HEADS, 2, PEER_NKEYS, PEER_QDIM // 2), (PEER_QDIM // 2) ** -0.5),
        'peer_u': nrm(ks[20], (DEPTH, PEER_N, D), D ** -0.5),
        'peer_v': nrm(ks[21], (DEPTH, PEER_N, D), PEER_HEADS ** -0.5),
        'final_g': 1.0 + nrm(ks[22], (D,), 0.02),
    }


def reference(x, c, ctx, c_ctx, w_mod, b_mod, norm1_g, norm2_g, w_in,
              lambda_q1, lambda_k1, lambda_q2, lambda_k2, subln_g, na_rpb,
              w_branch_a, w_branch_b, w_out, peer_w_q, peer_subkeys, peer_u, peer_v,
              final_g):
    S = x.shape[1]
    cos, sin = axial_rope_tables(S, x.dtype)
    for l in range(DEPTH):
        lam_init = 0.8 - 0.6 * math.exp(-0.3 * l)
        lam = (jnp.exp(jnp.sum(lambda_q1[l].astype(jnp.float32) * lambda_k1[l].astype(jnp.float32)))
               - jnp.exp(jnp.sum(lambda_q2[l].astype(jnp.float32) * lambda_k2[l].astype(jnp.float32)))
               + lam_init)
        sh1, sc1, gt1, sh2, sc2, gt2 = ada_params(c, w_mod[l], b_mod[l])
        sh1c, sc1c, gt1c, sh2c, sc2c, gt2c = ada_params(c_ctx[None, :], w_mod[l], b_mod[l])

        hx = modulate(x, norm1_g[l], sh1, sc1)
        hc = modulate(ctx, norm1_g[l], sh1c, sc1c)
        qa, ka, va, qb, kb, vb, ga, gb = split_proj(hx @ w_in[l])
        qa_c, ka_c, va_c, qb_c, kb_c, vb_c, ga_c, gb_c = split_proj(hc @ w_in[l])
        qa = apply_rope(qa, cos, sin)
        ka = apply_rope(ka, cos, sin)
        out_a = diff_attention(qa, jnp.concatenate([ka, ka_c], axis=1),
                               jnp.concatenate([va, va_c], axis=1), lam, lam_init, subln_g[l])
        out_b = neighbourhood_attention(qb, kb, vb, kb_c, vb_c, na_rpb[l])
        x_new = x + gt1 * merge(out_a, out_b, ga, gb, w_branch_a[l], w_branch_b[l], w_out[l])

        x_new = x_new + gt2 * peer(modulate(x_new, norm2_g[l], sh2, sc2),
                                   peer_w_q[l], peer_subkeys[l], peer_u[l], peer_v[l])

        if l < DEPTH - 1:
            ca = diff_attention(qa_c, ka_c, va_c, lam, lam_init, subln_g[l])
            cb = full_attention(qb_c, kb_c, vb_c)
            ctx = ctx + gt1c * merge(ca, cb, ga_c, gb_c, w_branch_a[l], w_branch_b[l], w_out[l])
            ctx = ctx + gt2c * peer(modulate(ctx, norm2_g[l], sh2c, sc2c),
                                    peer_w_q[l], peer_subkeys[l], peer_u[l], peer_v[l])
        x = x_new
    return rmsnorm(x, final_g)
```

```cpp
#include <hip/hip_runtime.h>
#include <cstdio>
#include <cstdint>

typedef unsigned short bf16_t;

#define DM 2048
#define SEQ 16384
#define CTXL 256
#define TOT (SEQ + CTXL)
#define NIN 10240
#define NMOD 12288

__device__ __forceinline__ float bf2f(bf16_t b) { return __uint_as_float(((unsigned)b) << 16); }
__device__ __forceinline__ bf16_t f2bf(float f) { unsigned u = __float_as_uint(f); u += 0x7FFFu + ((u >> 16) & 1u); return (bf16_t)(u >> 16); }
__device__ __forceinline__ float dpp_xor1(float v) { return __int_as_float(__builtin_amdgcn_update_dpp(0, __float_as_int(v), 0xB1, 0xF, 0xF, true)); }
__device__ __forceinline__ float dpp_xor2(float v) { return __int_as_float(__builtin_amdgcn_update_dpp(0, __float_as_int(v), 0x4E, 0xF, 0xF, true)); }
__device__ __forceinline__ float wave_sum(float v) { for (int o = 32; o >= 1; o >>= 1) v += __shfl_xor(v, o); return v; }
__device__ __forceinline__ float wave_max(float v) { for (int o = 32; o >= 1; o >>= 1) v = fmaxf(v, __shfl_xor(v, o)); return v; }
__device__ __forceinline__ float sigmoidf_(float x) { return 1.0f / (1.0f + __expf(-x)); }
__device__ __forceinline__ float gelu_tanh(float x) { const float u = 0.7978845608028654f * (x + 0.044715f * x * x * x); return 0.5f * x * (1.0f + tanhf(u)); }

struct WS {
  float* mod;
  float* misc;
  float* rope;
  bf16_t* hx;
  bf16_t* qa;
  bf16_t* ka;
  bf16_t* va;
  bf16_t* qb;
  bf16_t* kb;
  bf16_t* vb;
  bf16_t* sga;
  bf16_t* sgb;
  bf16_t* outa;
  bf16_t* outb;
  bf16_t* mrg;
  float* scores;
  int* pidx;
  float* pgate;
};

static WS make_ws(void* d_ws) {
  char* p = (char*)d_ws; WS w; size_t o = 0;
  auto take = [&](size_t bytes) { char* r = p + o; o += (bytes + 255) / 256 * 256; return r; };
  w.mod = (float*)take(2 * NMOD * 4); w.misc = (float*)take(256); w.rope = (float*)take(256 * 16 * 2 * 4);
  w.pidx = (int*)take((size_t)SEQ * 128 * 4); w.pgate = (float*)take((size_t)SEQ * 128 * 4);
  w.hx = (bf16_t*)take((size_t)TOT * DM * 2);
  w.outa = (bf16_t*)take((size_t)SEQ * 1024 * 2); w.outb = (bf16_t*)take((size_t)SEQ * 1024 * 2);
  w.qa = (bf16_t*)take((size_t)SEQ * 1024 * 2); w.ka = (bf16_t*)take((size_t)TOT * 1024 * 2);
  w.va = (bf16_t*)take((size_t)TOT * 1024 * 2); w.qb = (bf16_t*)take((size_t)SEQ * 1024 * 2);
  w.kb = (bf16_t*)take((size_t)TOT * 1024 * 2); w.vb = (bf16_t*)take((size_t)TOT * 1024 * 2);
  w.sga = (bf16_t*)take((size_t)SEQ * DM * 2); w.sgb = (bf16_t*)take((size_t)SEQ * DM * 2);
  w.mrg = w.qa;
  w.scores = (float*)w.va;
  return w;
}

__global__ __launch_bounds__(256) void k_ada(const float* __restrict__ c, const float* __restrict__ cctx, const float* __restrict__ wmod, const float* __restrict__ bmod,
                                             const float* lq1, const float* lk1, const float* lq2, const float* lk2, float* mod, float* misc, float* rope) {
  __shared__ float s[DM];
  const int cond = blockIdx.x / 48, j = (blockIdx.x % 48) * 256 + threadIdx.x;
  const float* cv = cond ? cctx : c;
  for (int k = threadIdx.x; k < DM; k += 256) { const float x = cv[k]; s[k] = x / (1.0f + expf(-x)); }
  __syncthreads();
  float acc = 0.f;
  for (int k = 0; k < DM; ++k) acc += s[k] * wmod[(size_t)k * NMOD + j];
  mod[cond * NMOD + j] = acc + bmod[j];
  if (blockIdx.x == 0 && threadIdx.x == 0) {
    float a = 0.f, b = 0.f; for (int i = 0; i < 64; ++i) { a += lq1[i] * lk1[i]; b += lq2[i] * lk2[i]; }
    misc[0] = expf(a) - expf(b) + 0.2f;
  }
  if (blockIdx.x == 1) {
    for (int e = threadIdx.x; e < 256 * 16; e += 256) { const int pos = e >> 4, i = e & 15; const float fr = powf(10000.0f, -(float)i / 16.0f); const float ang = (float)pos * fr;
      rope[e * 2] = cosf(ang); rope[e * 2 + 1] = sinf(ang); }
  }
}

__global__ __launch_bounds__(256) void k_modulate(const float* __restrict__ in, int nrows, const float* __restrict__ g, const float* __restrict__ shift, const float* __restrict__ scale, bf16_t* out) {
  const int wid = threadIdx.x >> 6, lane = threadIdx.x & 63;
  for (int r = blockIdx.x * 4 + wid; r < nrows; r += gridDim.x * 4) {
    const float* x = in + (size_t)r * DM; float v[32]; float ss = 0.f;
#pragma unroll
    for (int q = 0; q < 8; ++q) { const float4 t = *(const float4*)(x + q * 256 + lane * 4); v[q * 4] = t.x; v[q * 4 + 1] = t.y; v[q * 4 + 2] = t.z; v[q * 4 + 3] = t.w; ss += t.x * t.x + t.y * t.y + t.z * t.z + t.w * t.w; }
    ss = wave_sum(ss); const float rinv = rsqrtf(ss * (1.0f / DM) + 1e-6f);
#pragma unroll
    for (int q = 0; q < 8; ++q) { const int c0 = q * 256 + lane * 4; ushort4 o; bf16_t* op = (bf16_t*)&o;
#pragma unroll
      for (int j = 0; j < 4; ++j) op[j] = f2bf(v[q * 4 + j] * rinv * g[c0 + j] * (1.0f + scale[c0 + j]) + shift[c0 + j]);
      *(ushort4*)(out + (size_t)r * DM + c0) = o; }
  }
}

struct EpiInProj { WS w; const float* rope; };
struct EpiMerge1 { const bf16_t* sg; float* tmp; bf16_t* out; int second; };
struct EpiMerge2 { const float* x; const float* gt1; float* xnew; };
struct EpiPlain { bf16_t* out; int ld; };

__device__ __forceinline__ void epi_apply(const EpiInProj& e, int t, int n, float v, float pv) {
  const WS& w = e.w;
  if (n < 2048) {
    const bool isq = n < 1024; const int c = n & 1023;
    if (isq && t >= SEQ) return;
    float o = v;
    if (t < SEQ) { const int d = n & 63, i = d & 15, pos = (d < 32) ? (t >> 6) : (t & 63); const float cs = e.rope[(pos * 16 + i) * 2], sn = e.rope[(pos * 16 + i) * 2 + 1];
      o = v * cs + ((d & 16) ? pv : -pv) * sn; }
    if (isq) w.qa[(size_t)t * 1024 + c] = f2bf(o); else w.ka[(size_t)t * 1024 + c] = f2bf(o);
  } else if (n < 3072) w.va[(size_t)t * 1024 + (n - 2048)] = f2bf(v);
  else if (n < 4096) { if (t < SEQ) w.qb[(size_t)t * 1024 + (n - 3072)] = f2bf(v); }
  else if (n < 5120) w.kb[(size_t)t * 1024 + (n - 4096)] = f2bf(v);
  else if (n < 6144) w.vb[(size_t)t * 1024 + (n - 5120)] = f2bf(v);
  else if (n < 8192) { if (t < SEQ) w.sga[(size_t)t * DM + (n - 6144)] = f2bf(sigmoidf_(v)); }
  else { if (t < SEQ) w.sgb[(size_t)t * DM + (n - 8192)] = f2bf(sigmoidf_(v)); }
}
__device__ __forceinline__ void epi_apply(const EpiMerge1& e, int t, int n, float v, float) {
  const float s = bf2f(e.sg[(size_t)t * DM + n]) * v;
  if (!e.second) e.tmp[(size_t)t * DM + n] = s; else e.out[(size_t)t * DM + n] = f2bf(e.tmp[(size_t)t * DM + n] + s);
}
__device__ __forceinline__ void epi_apply(const EpiMerge2& e, int t, int n, float v, float) { e.xnew[(size_t)t * DM + n] = e.x[(size_t)t * DM + n] + e.gt1[n] * v; }
__device__ __forceinline__ void epi_apply(const EpiPlain& e, int t, int n, float v, float) { e.out[(size_t)t * e.ld + n] = f2bf(v); }

template <class Epi>
__global__ __launch_bounds__(256) void k_gemm_naive(const bf16_t* __restrict__ A, int lda, const float* __restrict__ W, int ldw, int M, int N, int K, Epi epi) {
  __shared__ float As[16][68]; __shared__ float Bs[16][68]; __shared__ float Cs[64][65];
  const int tid = threadIdx.x, tx = tid & 15, ty = tid >> 4;
  const int ntn = N / 64, tile = blockIdx.x, tm = tile / ntn, tn = tile % ntn, m0 = tm * 64, n0 = tn * 64;
  float acc[4][4] = {};
  const int ar = tid >> 2, ak = (tid & 3) * 4, bk = tid >> 4, bc = (tid & 15) * 4;
  for (int k0 = 0; k0 < K; k0 += 16) {
    const ushort4 a4 = *(const ushort4*)(A + (size_t)(m0 + ar) * lda + k0 + ak);
    const float4 b4 = *(const float4*)(W + (size_t)(k0 + bk) * ldw + n0 + bc);
    __syncthreads();
    As[ak][ar] = bf2f(a4.x); As[ak + 1][ar] = bf2f(a4.y); As[ak + 2][ar] = bf2f(a4.z); As[ak + 3][ar] = bf2f(a4.w);
    *(float4*)&Bs[bk][bc] = b4;
    __syncthreads();
#pragma unroll
    for (int k = 0; k < 16; ++k) { const float4 a = *(const float4*)&As[k][ty * 4]; const float4 b = *(const float4*)&Bs[k][tx * 4];
      const float av[4] = {a.x, a.y, a.z, a.w}, bv[4] = {b.x, b.y, b.z, b.w};
#pragma unroll
      for (int i = 0; i < 4; ++i)
#pragma unroll
        for (int j = 0; j < 4; ++j) acc[i][j] += av[i] * bv[j]; }
  }
#pragma unroll
  for (int i = 0; i < 4; ++i)
#pragma unroll
    for (int j = 0; j < 4; ++j) Cs[ty * 4 + i][tx * 4 + j] = acc[i][j];
  __syncthreads();
  for (int e = tid; e < 4096; e += 256) { const int r = e >> 6, c = e & 63; epi_apply(epi, m0 + r, n0 + c, Cs[r][c], Cs[r][c ^ 16]); }
}

__global__ __launch_bounds__(256) void k_diffattn_naive(const bf16_t* __restrict__ qa, const bf16_t* __restrict__ ka, const bf16_t* __restrict__ va, const float* __restrict__ subln, const float* __restrict__ misc, bf16_t* outa) {
  const int g = blockIdx.x * 256 + threadIdx.x, sub = g & 3, item = g >> 2, i = item & 1, h = (item >> 1) & 7, t = item >> 4;
  float q[16], o[32];
  { const bf16_t* qp = qa + (size_t)t * 1024 + h * 128 + i * 64 + sub * 16;
#pragma unroll
    for (int d = 0; d < 16; ++d) q[d] = bf2f(qp[d]) * 0.125f; }
#pragma unroll
  for (int d = 0; d < 32; ++d) o[d] = 0.f;
  float m = -1e30f, l = 0.f;
  const bf16_t* kp = ka + h * 128 + i * 64 + sub * 16; const bf16_t* vp = va + h * 128 + sub * 32;
  for (int k = 0; k < TOT; ++k) {
    const uint4 k0 = *(const uint4*)(kp + (size_t)k * 1024), k1 = *(const uint4*)(kp + (size_t)k * 1024 + 8);
    const unsigned kw[8] = {k0.x, k0.y, k0.z, k0.w, k1.x, k1.y, k1.z, k1.w};
    float s = 0.f;
#pragma unroll
    for (int d = 0; d < 8; ++d) { s += q[2 * d] * __uint_as_float(kw[d] << 16); s += q[2 * d + 1] * __uint_as_float(kw[d] & 0xffff0000u); }
    s += dpp_xor1(s); s += dpp_xor2(s);
    if (s > m) { const float a = __expf(m - s); l *= a;
#pragma unroll
      for (int d = 0; d < 32; ++d) o[d] *= a;
      m = s; }
    const float p = __expf(s - m); l += p;
    const uint4* vv = (const uint4*)(vp + (size_t)k * 1024);
#pragma unroll
    for (int c = 0; c < 4; ++c) { const uint4 x = vv[c]; const unsigned xw[4] = {x.x, x.y, x.z, x.w};
#pragma unroll
      for (int d = 0; d < 4; ++d) { o[c * 8 + 2 * d] += p * __uint_as_float(xw[d] << 16); o[c * 8 + 2 * d + 1] += p * __uint_as_float(xw[d] & 0xffff0000u); } }
  }
  const float lam = misc[0], rl = 1.0f / l; float ss = 0.f;
#pragma unroll
  for (int d = 0; d < 32; ++d) { const float mine = o[d] * rl; const float other = __shfl_xor(mine, 4); const float r = i ? (other - lam * mine) : (mine - lam * other); o[d] = r; ss += r * r; }
  ss += dpp_xor1(ss); ss += dpp_xor2(ss);
  const float rinv = rsqrtf(ss * (1.0f / 128.0f) + 1e-6f) * 0.8f;
  if (i == 0) {
#pragma unroll
    for (int d = 0; d < 32; ++d) outa[(size_t)t * 1024 + h * 128 + sub * 32 + d] = f2bf(o[d] * rinv * subln[sub * 32 + d]);
  }
}

__global__ __launch_bounds__(256) void k_na_naive(const bf16_t* __restrict__ qb, const bf16_t* __restrict__ kb, const bf16_t* __restrict__ vb, const float* __restrict__ rpb, bf16_t* outb) {
  const int g = blockIdx.x * 256 + threadIdx.x, sub = g & 3, item = g >> 2, h = item & 7, t = item >> 3;
  const int r = t >> 6, c = t & 63; int rs = r - 4; rs = rs < 0 ? 0 : (rs > 248 ? 248 : rs); int cs = c - 8; cs = cs < 0 ? 0 : (cs > 48 ? 48 : cs);
  float q[32], o[32];
  { const bf16_t* qp = qb + (size_t)t * 1024 + h * 128 + sub * 32;
#pragma unroll
    for (int d = 0; d < 32; ++d) { q[d] = bf2f(qp[d]) * 0.08838834764831845f; o[d] = 0.f; } }
  float m = -1e30f, l = 0.f;
  for (int k = 0; k < 128 + CTXL; ++k) {
    int kt; float bias = 0.f;
    if (k < 128) { const int i = k >> 4, j = k & 15; kt = (rs + i) * 64 + cs + j; bias = rpb[(h * 15 + (rs + i - r + 7)) * 31 + (cs + j - c + 15)]; } else kt = SEQ + (k - 128);
    const bf16_t* kp = kb + (size_t)kt * 1024 + h * 128 + sub * 32; const bf16_t* vp = vb + (size_t)kt * 1024 + h * 128 + sub * 32;
    float s = 0.f;
#pragma unroll
    for (int cc = 0; cc < 4; ++cc) { const uint4 x = ((const uint4*)kp)[cc]; const unsigned xw[4] = {x.x, x.y, x.z, x.w};
#pragma unroll
      for (int d = 0; d < 4; ++d) { s += q[cc * 8 + 2 * d] * __uint_as_float(xw[d] << 16); s += q[cc * 8 + 2 * d + 1] * __uint_as_float(xw[d] & 0xffff0000u); } }
    s += dpp_xor1(s); s += dpp_xor2(s); s += bias;
    if (s > m) { const float a = __expf(m - s); l *= a;
#pragma unroll
      for (int d = 0; d < 32; ++d) o[d] *= a;
      m = s; }
    const float p = __expf(s - m); l += p;
#pragma unroll
    for (int cc = 0; cc < 4; ++cc) { const uint4 x = ((const uint4*)vp)[cc]; const unsigned xw[4] = {x.x, x.y, x.z, x.w};
#pragma unroll
      for (int d = 0; d < 4; ++d) { o[cc * 8 + 2 * d] += p * __uint_as_float(xw[d] << 16); o[cc * 8 + 2 * d + 1] += p * __uint_as_float(xw[d] & 0xffff0000u); } }
  }
  const float rl = 1.0f / l;
#pragma unroll
  for (int d = 0; d < 32; ++d) outb[(size_t)t * 1024 + h * 128 + sub * 32 + d] = f2bf(o[d] * rl);
}

__global__ __launch_bounds__(256) void k_peer_scores(const bf16_t* __restrict__ qp, const float* __restrict__ subkeys, float* scores) {
  const size_t g = (size_t)blockIdx.x * 256 + threadIdx.x;
  const int key = g & 127, hp = (g >> 7) & 15; const size_t t = g >> 11;
  const bf16_t* q = qp + t * DM + hp * 128; const float* sk = subkeys + ((size_t)hp * 128 + key) * 128;
  float s = 0.f;
  for (int d = 0; d < 128; d += 4) { const float4 k4 = *(const float4*)(sk + d); const ushort4 q4 = *(const ushort4*)(q + d);
    s += bf2f(q4.x) * k4.x + bf2f(q4.y) * k4.y + bf2f(q4.z) * k4.z + bf2f(q4.w) * k4.w; }
  scores[g] = s;
}

template <int NS>
__device__ __forceinline__ void wave_top16(float (&v)[NS], int lane, float& selv, int& sele) {
  selv = 0.f; sele = 0;
  for (int r = 0; r < 16; ++r) {
    float m = v[0];
#pragma unroll
    for (int s = 1; s < NS; ++s) m = fmaxf(m, v[s]);
    const float M = wave_max(m);
    int e = -1;
#pragma unroll
    for (int s = 0; s < NS; ++s) { if (e < 0) { const unsigned long long b = __ballot(v[s] == M); if (b) { const int L = __ffsll((long long)b) - 1; e = s * 64 + L; if (lane == L) v[s] = -3.0e38f; } } }
    if (lane == r) { selv = M; sele = e; }
  }
}

__global__ __launch_bounds__(256) void k_peer_topk(const float* __restrict__ scores, int* pidx, float* pgate) {
  const int wid = threadIdx.x >> 6, lane = threadIdx.x & 63; const int th = blockIdx.x * 4 + wid;
  const float* s1 = scores + (size_t)th * 256; const float* s2 = s1 + 128;
  float a[2] = {s1[lane], s1[64 + lane]}, b[2] = {s2[lane], s2[64 + lane]};
  float v1, v2; int e1, e2; wave_top16<2>(a, lane, v1, e1); wave_top16<2>(b, lane, v2, e2);
  float cv[4]; int ci[4];
#pragma unroll
  for (int m = 0; m < 4; ++m) { const int i = m * 4 + (lane >> 4), j = lane & 15; cv[m] = __shfl(v1, i) + __shfl(v2, j); ci[m] = __shfl(e1, i) * 128 + __shfl(e2, j); }
  float bv; int be; wave_top16<4>(cv, lane, bv, be);
  int idx = 0;
#pragma unroll
  for (int m = 0; m < 4; ++m) { const int cand = __shfl(ci[m], be & 63); if ((be >> 6) == m) idx = cand; }
  const float mx = __shfl(bv, 0); float ex = lane < 16 ? __expf(bv - mx) : 0.f; const float sum = wave_sum(ex);
  if (lane < 16) { pidx[(size_t)th * 16 + lane] = idx; pgate[(size_t)th * 16 + lane] = ex / sum; }
}

__global__ __launch_bounds__(256) void k_peer_expert(float* xio  , const float* __restrict__ g2, const float* __restrict__ mod, const int* __restrict__ pidx, const float* __restrict__ pgate,
                                                    const float* __restrict__ U, const float* __restrict__ V, const float* __restrict__ fg) {
  const int wid = threadIdx.x >> 6, lane = threadIdx.x & 63; const int t = blockIdx.x * 4 + wid;
  const float* sh2 = mod + 3 * DM; const float* sc2 = mod + 4 * DM; const float* gt2 = mod + 5 * DM;
  float xn[32], h2[32], out[32]; float ss = 0.f;
#pragma unroll
  for (int q = 0; q < 8; ++q) { const float4 v = *(const float4*)(xio + (size_t)t * DM + q * 256 + lane * 4); xn[q * 4] = v.x; xn[q * 4 + 1] = v.y; xn[q * 4 + 2] = v.z; xn[q * 4 + 3] = v.w; ss += v.x * v.x + v.y * v.y + v.z * v.z + v.w * v.w; }
  ss = wave_sum(ss); const float rinv = rsqrtf(ss * (1.0f / DM) + 1e-6f);
#pragma unroll
  for (int q = 0; q < 8; ++q)
#pragma unroll
    for (int j = 0; j < 4; ++j) { const int c = q * 256 + lane * 4 + j; h2[q * 4 + j] = xn[q * 4 + j] * rinv * g2[c] * (1.0f + sc2[c]) + sh2[c]; out[q * 4 + j] = 0.f; }
  for (int e = 0; e < 128; ++e) {
    const int id = pidx[(size_t)t * 128 + e]; const float gate = pgate[(size_t)t * 128 + e];
    const float* u = U + (size_t)id * DM; const float* v = V + (size_t)id * DM; float d = 0.f;
#pragma unroll
    for (int q = 0; q < 8; ++q) { const float4 x = *(const float4*)(u + q * 256 + lane * 4); d += h2[q * 4] * x.x + h2[q * 4 + 1] * x.y + h2[q * 4 + 2] * x.z + h2[q * 4 + 3] * x.w; }
    d = wave_sum(d); const float a = gate * gelu_tanh(d);
#pragma unroll
    for (int q = 0; q < 8; ++q) { const float4 x = *(const float4*)(v + q * 256 + lane * 4); out[q * 4] += a * x.x; out[q * 4 + 1] += a * x.y; out[q * 4 + 2] += a * x.z; out[q * 4 + 3] += a * x.w; }
  }
  float s2 = 0.f;
#pragma unroll
  for (int q = 0; q < 8; ++q)
#pragma unroll
    for (int j = 0; j < 4; ++j) { const int c = q * 256 + lane * 4 + j; const float y = xn[q * 4 + j] + gt2[c] * out[q * 4 + j]; xn[q * 4 + j] = y; s2 += y * y; }
  s2 = wave_sum(s2); const float r2 = rsqrtf(s2 * (1.0f / DM) + 1e-6f);
#pragma unroll
  for (int q = 0; q < 8; ++q) { const int c = q * 256 + lane * 4; float4 o; o.x = xn[q * 4] * r2 * fg[c]; o.y = xn[q * 4 + 1] * r2 * fg[c + 1]; o.z = xn[q * 4 + 2] * r2 * fg[c + 2]; o.w = xn[q * 4 + 3] * r2 * fg[c + 3];
    *(float4*)(xio + (size_t)t * DM + c) = o; }
}

extern "C" void kernel_launch(void* const* d_in, const int* in_sizes, int n_in, void* d_out, int out_size, void* d_ws, size_t ws_size, hipStream_t stream) {
  const float* x = (const float*)d_in[0]; const float* c = (const float*)d_in[1]; const float* ctx = (const float*)d_in[2]; const float* cctx = (const float*)d_in[3];
  const float* wmod = (const float*)d_in[4]; const float* bmod = (const float*)d_in[5]; const float* g1 = (const float*)d_in[6]; const float* g2 = (const float*)d_in[7];
  const float* win = (const float*)d_in[8]; const float* lq1 = (const float*)d_in[9]; const float* lk1 = (const float*)d_in[10]; const float* lq2 = (const float*)d_in[11]; const float* lk2 = (const float*)d_in[12];
  const float* subln = (const float*)d_in[13]; const float* rpb = (const float*)d_in[14]; const float* wa = (const float*)d_in[15]; const float* wb = (const float*)d_in[16]; const float* wo = (const float*)d_in[17];
  const float* wq = (const float*)d_in[18]; const float* subkeys = (const float*)d_in[19]; const float* U = (const float*)d_in[20]; const float* V = (const float*)d_in[21]; const float* fg = (const float*)d_in[22];
  float* out = (float*)d_out;
  WS w = make_ws(d_ws);
  const float* modc = w.mod; const float* modx = w.mod + NMOD;
  k_ada<<<96, 256, 0, stream>>>(c, cctx, wmod, bmod, lq1, lk1, lq2, lk2, w.mod, w.misc, w.rope);
  k_modulate<<<2048, 256, 0, stream>>>(x, SEQ, g1, modc + 0, modc + DM, w.hx);
  k_modulate<<<64, 256, 0, stream>>>(ctx, CTXL, g1, modx + 0, modx + DM, w.hx + (size_t)SEQ * DM);
  { EpiInProj e; e.w = w; e.rope = w.rope; k_gemm_naive<EpiInProj><<<(TOT / 64) * (NIN / 64), 256, 0, stream>>>(w.hx, DM, win, NIN, TOT, NIN, DM, e); }
  k_diffattn_naive<<<(SEQ * 8 * 2 * 4) / 256, 256, 0, stream>>>(w.qa, w.ka, w.va, subln, w.misc, w.outa);
  k_na_naive<<<(SEQ * 8 * 4) / 256, 256, 0, stream>>>(w.qb, w.kb, w.vb, rpb, w.outb);
  { EpiMerge1 e; e.sg = w.sga; e.tmp = out; e.out = w.mrg; e.second = 0; k_gemm_naive<EpiMerge1><<<(SEQ / 64) * (DM / 64), 256, 0, stream>>>(w.outa, 1024, wa, DM, SEQ, DM, 1024, e);
    e.sg = w.sgb; e.second = 1; k_gemm_naive<EpiMerge1><<<(SEQ / 64) * (DM / 64), 256, 0, stream>>>(w.outb, 1024, wb, DM, SEQ, DM, 1024, e); }
  { EpiMerge2 e; e.x = x; e.gt1 = modc + 2 * DM; e.xnew = out; k_gemm_naive<EpiMerge2><<<(SEQ / 64) * (DM / 64), 256, 0, stream>>>(w.mrg, DM, wo, DM, SEQ, DM, DM, e); }
  k_modulate<<<2048, 256, 0, stream>>>(out, SEQ, g2, modc + 3 * DM, modc + 4 * DM, w.hx);
  { EpiPlain e; e.out = w.sga; e.ld = DM; k_gemm_naive<EpiPlain><<<(SEQ / 64) * (DM / 64), 256, 0, stream>>>(w.hx, DM, wq, DM, SEQ, DM, DM, e); }
  k_peer_scores<<<(unsigned)(((size_t)SEQ * 2048) / 256), 256, 0, stream>>>(w.sga, subkeys, w.scores);
  k_peer_topk<<<SEQ * 8 / 4, 256, 0, stream>>>(w.scores, w.pidx, w.pgate);
  k_peer_expert<<<SEQ / 4, 256, 0, stream>>>(out, g2, modc, w.pidx, w.pgate, U, V, fg);
}
```

```cpp
#include <hip/hip_runtime.h>
#include <cstdio>
#include <cstdint>

typedef unsigned short bf16_t;

#define DM 2048
#define SEQ 16384
#define CTXL 256
#define TOT (SEQ + CTXL)
#define NIN 10240
#define NMOD 12288
#define XCD_BAR_WORDS 3456

__device__ __forceinline__ float bf2f(bf16_t b) { return __uint_as_float(((unsigned)b) << 16); }
__device__ __forceinline__ bf16_t f2bf(float f) { unsigned u = __float_as_uint(f); u += 0x7FFFu + ((u >> 16) & 1u); return (bf16_t)(u >> 16); }
__device__ __forceinline__ float dpp_xor1(float v) { return __int_as_float(__builtin_amdgcn_update_dpp(0, __float_as_int(v), 0xB1, 0xF, 0xF, true)); }
__device__ __forceinline__ float dpp_xor2(float v) { return __int_as_float(__builtin_amdgcn_update_dpp(0, __float_as_int(v), 0x4E, 0xF, 0xF, true)); }
__device__ __forceinline__ float wave_sum(float v) { for (int o = 32; o >= 1; o >>= 1) v += __shfl_xor(v, o); return v; }
__device__ __forceinline__ float wave_max(float v) { for (int o = 32; o >= 1; o >>= 1) v = fmaxf(v, __shfl_xor(v, o)); return v; }
__device__ __forceinline__ float sigmoidf_(float x) { return 1.0f / (1.0f + __expf(-x)); }
__device__ __forceinline__ float gelu_tanh(float x) { const float u = 0.7978845608028654f * (x + 0.044715f * x * x * x); return 0.5f * x * (1.0f + tanhf(u)); }

struct WS {
  float* mod;
  float* misc;
  float* rope;
  bf16_t* hx;
  bf16_t* qa;
  bf16_t* ka;
  bf16_t* va;
  bf16_t* qb;
  bf16_t* kb;
  bf16_t* vb;
  bf16_t* sga;
  bf16_t* sgb;
  bf16_t* outa;
  bf16_t* outb;
  bf16_t* mrg;
  float* scores;
  int* pidx;
  float* pgate;
  float* rcos;
  float* rsin;
  bf16_t* wt_in;
  bf16_t* wt_ab;
  bf16_t* wt_o;
  bf16_t* wt_q;
  unsigned char* u8; unsigned char* v8;
  float* uscale; float* vscale;
  unsigned* bar;
  float* part;
  unsigned* kmax;
};

static WS make_ws(void* d_ws) {
  char* p = (char*)d_ws; WS w; size_t o = 0;
  auto take = [&](size_t bytes) { char* r = p + o; o += (bytes + 255) / 256 * 256; return r; };
  w.bar = (unsigned*)take((XCD_BAR_WORDS + 64) * 4); w.kmax = w.bar + XCD_BAR_WORDS;
  w.part = (float*)take((size_t)32 * 2 * NMOD * 4);
  w.mod = (float*)take(2 * NMOD * 4); w.misc = (float*)take(256); w.rope = (float*)take(256 * 16 * 2 * 4);
  w.pidx = (int*)take((size_t)SEQ * 128 * 4); w.pgate = (float*)take((size_t)SEQ * 128 * 4);
  w.hx = (bf16_t*)take((size_t)TOT * DM * 2);
  w.outa = (bf16_t*)take((size_t)SEQ * 2048 * 2); w.outb = w.outa + 1024;
  w.rcos = (float*)take(256 * 16 * 4); w.rsin = (float*)take(256 * 16 * 4);
  w.wt_in = (bf16_t*)take((size_t)NIN * DM * 2); w.wt_ab = (bf16_t*)take((size_t)DM * DM * 2); w.wt_o = (bf16_t*)take((size_t)DM * DM * 2); w.wt_q = (bf16_t*)take((size_t)DM * DM * 2);
  w.u8 = (unsigned char*)take((size_t)16384 * DM); w.v8 = (unsigned char*)take((size_t)16384 * DM); w.uscale = (float*)take(16384 * 4); w.vscale = (float*)take(16384 * 4);
  w.qa = (bf16_t*)take((size_t)SEQ * 1024 * 2); w.ka = (bf16_t*)take((size_t)TOT * 1024 * 2);
  w.va = (bf16_t*)take((size_t)TOT * 1024 * 2); w.qb = (bf16_t*)take((size_t)SEQ * 1024 * 2);
  w.kb = (bf16_t*)take((size_t)TOT * 1024 * 2); w.vb = (bf16_t*)take((size_t)TOT * 1024 * 2);
  w.sga = (bf16_t*)take((size_t)SEQ * DM * 2); w.sgb = (bf16_t*)take((size_t)SEQ * DM * 2);
  w.mrg = w.qa;
  w.scores = (float*)w.va;
  return w;
}

__device__ __forceinline__ void g_modulate(int vb, int nvb, int tid, const float* __restrict__ in, int nrows, const float* __restrict__ g, const float* __restrict__ shift, const float* __restrict__ scale, bf16_t* out, unsigned char* out8 = nullptr) {
  const int wid = tid >> 6, lane = tid & 63;
  for (int r = vb * 4 + wid; r < nrows; r += nvb * 4) {
    const float* x = in + (size_t)r * DM; float v[32]; float ss = 0.f;
#pragma unroll
    for (int q = 0; q < 8; ++q) { const float4 t = *(const float4*)(x + q * 256 + lane * 4); v[q * 4] = t.x; v[q * 4 + 1] = t.y; v[q * 4 + 2] = t.z; v[q * 4 + 3] = t.w; ss += t.x * t.x + t.y * t.y + t.z * t.z + t.w * t.w; }
    ss = wave_sum(ss); const float rinv = rsqrtf(ss * (1.0f / DM) + 1e-6f);
#pragma unroll
    for (int q = 0; q < 8; ++q) { const int c0 = q * 256 + lane * 4; ushort4 o; bf16_t* op = (bf16_t*)&o;
      float hv[4];
#pragma unroll
      for (int j = 0; j < 4; ++j) { hv[j] = v[q * 4 + j] * rinv * g[c0 + j] * (1.0f + scale[c0 + j]) + shift[c0 + j]; op[j] = f2bf(hv[j]); }
      *(ushort4*)(out + (size_t)r * DM + c0) = o;
      if (out8) { int pk = 0; pk = __builtin_amdgcn_cvt_pk_fp8_f32(hv[0] * 8.0f, hv[1] * 8.0f, pk, false); pk = __builtin_amdgcn_cvt_pk_fp8_f32(hv[2] * 8.0f, hv[3] * 8.0f, pk, true); *(unsigned*)(out8 + (size_t)r * DM + c0) = (unsigned)pk; } }
  }
}

namespace pg8 {
#define PG8_LAS __attribute__((address_space(3)))
typedef short bf16x8 __attribute__((ext_vector_type(8)));
typedef float f32x4 __attribute__((ext_vector_type(4)));
typedef unsigned u32x4 __attribute__((ext_vector_type(4)));
typedef int i32x4 __attribute__((ext_vector_type(4)));
typedef int i32x8 __attribute__((ext_vector_type(8)));
typedef float f32x16 __attribute__((ext_vector_type(16)));
__host__ __device__ __forceinline__ int perm32f8(int rho) { return 16 * ((rho >> 2) & 1) + (rho & 3) + 4 * (rho >> 3); }
constexpr int BM = 256, BK = 64, HALF = 128, HTB = HALF * BK * 2, STAGE_BYTES = 8 * HTB, NXCD = 8, WGM = 8;
__host__ __device__ __forceinline__ int lds_byte(int r, int c) { const int st = (r >> 4) * 2 + (c >> 5), rr = r & 15, cc = c & 31, ob = rr * 64 + cc * 2; return st * 1024 + (ob ^ (((ob >> 9) & 1) << 5)); }
__host__ __device__ __forceinline__ void stage_rc(int b, int& R, int& C) { const int st = b / 1024, sb = b % 1024, swz = sb ^ (((sb >> 9) & 1) << 5); R = (st >> 1) * 16 + swz / 64; C = (st & 1) * 32 + (swz % 64) / 2; }
__host__ __device__ __forceinline__ int perm32(int rho) { const int n = rho >> 4, i = rho & 15; return 8 * (i >> 2) + 4 * n + (i & 3); }
struct Unit { int pm, pn; };
struct Gemm { const bf16_t* A; const bf16_t* Bt; int M, N, K; };
__device__ __forceinline__ unsigned cvt_pk_bf16(float lo, float hi) { unsigned r; asm volatile("v_cvt_pk_bf16_f32 %0, %1, %2" : "=v"(r) : "v"(lo), "v"(hi)); return r; }

struct StaticOrder {
    int nM, nN, nwg, G, c;
    __device__ void init(int M, int N, int G_, int c_) { nM = M / BM; nN = N / BM; nwg = nM * nN; G = G_; c = c_; }
    __device__ bool next(int i, Unit& u) const {
        const long L = (long)i * G + c; if (L >= nwg) return false;
        int wgid = (int)L; { const int q = nwg / NXCD, r = nwg % NXCD, xcd = wgid % NXCD, off = wgid / NXCD; wgid = (xcd < r ? xcd * (q + 1) : r * (q + 1) + (xcd - r) * q) + off; }
        const int nig = WGM * nN, gid = wgid / nig, fm = gid * WGM, gsz = (nM - fm) < WGM ? (nM - fm) : WGM;
        u.pm = fm + ((wgid % nig) % gsz); u.pn = (wgid % nig) / gsz; return true;
    }
};
struct InProjOrder {
    StaticOrder s;
    __device__ void init(int G_, int c_) { s.init(SEQ, NIN, G_, c_); }
    __device__ bool next(int i, Unit& u) const {
        const long L = (long)i * s.G + s.c;
        if (L < s.nwg) return s.next(i, u);
        const int j = (int)(L - s.nwg); if (j >= 16) return false;
        u.pm = 64; u.pn = j < 8 ? 4 + j : 8 + j; return true;
    }
};

template <class Epi, class Sched>
__device__ __forceinline__ void gemm_phase(PG8_LAS unsigned char* lds, const Gemm g, const Sched& S, const Epi& E) {
    int tid = threadIdx.x; asm volatile("" : "+v"(tid));
    const int wid = __builtin_amdgcn_readfirstlane(tid >> 6), lane = tid & 63, wr = wid >> 2, wc = wid & 3, fr = lane & 15, fq = lane >> 4;
    const int K = g.K, nt = K / BK;
    unsigned voffA[2], voffB[2];
#pragma unroll
    for (int i = 0; i < 2; ++i) { int R, C; stage_rc(tid * 16 + i * 8192, R, C); const int Rb = Epi::PERM ? ((R & ~31) + perm32(R & 31)) : R;
        voffA[i] = (unsigned)(R * K + C) * 2u; voffB[i] = (unsigned)(Rb * K + C) * 2u; }
    const size_t kstep = (size_t)(BK * 2);
    const size_t hstep = (size_t)HALF * K * 2;
    const size_t tstep = 2 * hstep;
    const unsigned ldsw = (unsigned)wid * 1024u;
    const int aoff = lds_byte(wr * 64 + fr, fq * 8), boff = lds_byte(wc * 32 + fr, fq * 8);
#define PG8_SA(b, h) (((b) * 2 + (h)) * HTB)
#define PG8_SB(b, h) ((4 + (b) * 2 + (h)) * HTB)
#define PG8_STAGE(bufoff, gbase, voff) do { _Pragma("unroll") for (int _i = 0; _i < 2; ++_i) \
        __builtin_amdgcn_global_load_lds((const unsigned*)((const char*)(gbase) + (voff)[_i]), (PG8_LAS unsigned*)(lds + (bufoff) + ldsw + _i * 8192), 16, 0, 0); } while (0)
#define PG8_LDA(dst, b, h) do { _Pragma("unroll") for (int m = 0; m < 4; ++m) _Pragma("unroll") for (int k = 0; k < 2; ++k) dst[m][k] = *(const PG8_LAS bf16x8*)(lds + PG8_SA(b, h) + aoff + m * 2048 + k * 1024); } while (0)
#define PG8_LDB(dst, b, h) do { _Pragma("unroll") for (int n = 0; n < 2; ++n) _Pragma("unroll") for (int k = 0; k < 2; ++k) dst[n][k] = *(const PG8_LAS bf16x8*)(lds + PG8_SB(b, h) + boff + n * 2048 + k * 1024); } while (0)
#define PG8_MMA(ai, bj, At, Bt) do { __builtin_amdgcn_s_setprio(1); _Pragma("unroll") for (int m = 0; m < 4; ++m) _Pragma("unroll") for (int n = 0; n < 2; ++n) _Pragma("unroll") for (int k = 0; k < 2; ++k) \
        acc[ai][bj][m][n] = __builtin_amdgcn_mfma_f32_16x16x32_bf16(Bt[n][k], At[m][k], acc[ai][bj][m][n], 0, 0, 0); __builtin_amdgcn_s_setprio(0); } while (0)
#define PG8_WAIT_V(n) asm volatile("s_waitcnt vmcnt(" #n ")" ::: "memory")
#define PG8_WAIT_L(n) asm volatile("s_waitcnt lgkmcnt(" #n ")" ::: "memory")
#define PG8_BAR __builtin_amdgcn_s_barrier()
#define PG8_SCHED __builtin_amdgcn_sched_barrier(0)
#define PG8_KBODY \
            const bool last = (t == nt - 2); \
            const char* a1 = cA + (size_t)(t + 1) * kstep; \
            const char* a2 = last ? nA : cA + (size_t)(t + 2) * kstep; const char* b2 = last ? nB : cB + (size_t)(t + 2) * kstep; \
            const char* a3 = a2 + kstep; const char* b3 = b2 + kstep; \
            PG8_LDB(B0, 0, 0); PG8_SCHED; PG8_LDA(At, 0, 0); PG8_STAGE(PG8_SA(1, 1), a1 + hstep, voffA); \
            PG8_WAIT_L(8); PG8_BAR; PG8_WAIT_L(0); PG8_MMA(0, 0, At, B0); PG8_BAR; PG8_SCHED; \
            PG8_LDB(B1, 0, 1); PG8_STAGE(PG8_SB(0, 0), b2, voffB); \
            PG8_BAR; PG8_WAIT_L(0); PG8_MMA(0, 1, At, B1); PG8_BAR; \
            PG8_LDA(At, 0, 1); PG8_STAGE(PG8_SA(0, 0), a2, voffA); \
            PG8_BAR; PG8_WAIT_L(0); PG8_MMA(1, 0, At, B0); PG8_BAR; PG8_SCHED; \
            PG8_STAGE(PG8_SB(0, 1), b2 + hstep, voffB); \
            PG8_WAIT_V(6); PG8_BAR; PG8_MMA(1, 1, At, B1); PG8_BAR; \
            PG8_LDB(B0, 1, 0); PG8_SCHED; PG8_LDA(At, 1, 0); PG8_STAGE(PG8_SA(0, 1), a2 + hstep, voffA); \
            PG8_WAIT_L(8); PG8_BAR; PG8_WAIT_L(0); PG8_MMA(0, 0, At, B0); PG8_BAR; PG8_SCHED; \
            PG8_LDB(B1, 1, 1); PG8_STAGE(PG8_SB(1, 0), b3, voffB); \
            PG8_BAR; PG8_WAIT_L(0); PG8_MMA(0, 1, At, B1); PG8_BAR; \
            PG8_LDA(At, 1, 1); PG8_STAGE(PG8_SA(1, 0), a3, voffA); \
            PG8_BAR; PG8_WAIT_L(0); PG8_MMA(1, 0, At, B0); PG8_BAR; PG8_SCHED; \
            PG8_STAGE(PG8_SB(1, 1), b3 + hstep, voffB); \
            PG8_WAIT_V(6); PG8_BAR; PG8_MMA(1, 1, At, B1); PG8_BAR;
    Unit cur, nxt; int ui = 0;
    if (!S.next(0, cur)) return;
    f32x4 acc[2][2][4][2];
#pragma unroll
    for (int a = 0; a < 2; ++a)
#pragma unroll
        for (int b = 0; b < 2; ++b)
#pragma unroll
            for (int m = 0; m < 4; ++m)
#pragma unroll
                for (int n = 0; n < 2; ++n) acc[a][b][m][n] = (f32x4){0.f, 0.f, 0.f, 0.f};
    bf16x8 At[4][2], B0[2][2], B1[2][2];
    const char* cA = (const char*)g.A + (size_t)cur.pm * tstep; const char* cB = (const char*)g.Bt + (size_t)cur.pn * tstep;
    PG8_STAGE(PG8_SB(0, 0), cB, voffB); PG8_STAGE(PG8_SA(0, 0), cA, voffA); PG8_STAGE(PG8_SB(0, 1), cB + hstep, voffB); PG8_STAGE(PG8_SA(0, 1), cA + hstep, voffA);
    if (wr == 1) PG8_BAR;
    PG8_WAIT_V(4); PG8_BAR;
    PG8_STAGE(PG8_SB(1, 0), cB + kstep, voffB); PG8_STAGE(PG8_SA(1, 0), cA + kstep, voffA); PG8_STAGE(PG8_SB(1, 1), cB + hstep + kstep, voffB);
    PG8_WAIT_V(6); PG8_BAR;
    for (;;) {
        const bool has_next = S.next(ui + 1, nxt);
        const char* nA = has_next ? (const char*)g.A + (size_t)nxt.pm * tstep : cA; const char* nB = has_next ? (const char*)g.Bt + (size_t)nxt.pn * tstep : cB;
        if constexpr (Epi::MID_T > 0) {
            for (int t = 0; t < Epi::MID_T; t += 2) { PG8_KBODY }
            E.mid(acc, cur, wr, wc, fr, fq);
            for (int t = Epi::MID_T; t < nt; t += 2) { PG8_KBODY }
        } else {
            for (int t = 0; t < nt; t += 2) { PG8_KBODY }
        }
        E(acc, cur, wr, wc, fr, fq);
        if (!has_next) break;
#pragma unroll
        for (int a = 0; a < 2; ++a)
#pragma unroll
            for (int b = 0; b < 2; ++b)
#pragma unroll
                for (int m = 0; m < 4; ++m)
#pragma unroll
                    for (int n = 0; n < 2; ++n) acc[a][b][m][n] = (f32x4){0.f, 0.f, 0.f, 0.f};
        cur = nxt; cA = nA; cB = nB; ++ui;
    }
    PG8_WAIT_V(0);
    if (wr == 0) PG8_BAR;
    PG8_BAR;
#undef PG8_KBODY
#undef PG8_SA
#undef PG8_SB
#undef PG8_STAGE
#undef PG8_LDA
#undef PG8_LDB
#undef PG8_MMA
#undef PG8_WAIT_V
#undef PG8_WAIT_L
#undef PG8_BAR
#undef PG8_SCHED
}

struct EpiInProjM {
    static constexpr bool PERM = true; static constexpr int MID_T = 0;
    WS w; const float* rcos; const float* rsin;
    static constexpr float QC = 0.125f * 1.4426950408889634f;
    __device__ __forceinline__ void operator()(const f32x4 (&acc)[2][2][4][2], const Unit& u, int wr, int wc, int fr, int fq) const {
        asm volatile("" : "+v"(fr), "+v"(fq));
        const int pn = u.pn; bf16_t* base; int ld = 1024, colt; int kind;
        if (pn < 4) { base = w.qa; colt = pn * 256; kind = 1; } else if (pn < 8) { base = w.ka; colt = (pn - 4) * 256; kind = 1; }
        else if (pn < 12) { base = w.va; colt = (pn - 8) * 256; kind = 0; } else if (pn < 16) { base = w.qb; colt = (pn - 12) * 256; kind = 0; }
        else if (pn < 20) { base = w.kb; colt = (pn - 16) * 256; kind = 0; } else if (pn < 24) { base = w.vb; colt = (pn - 20) * 256; kind = 0; }
        else if (pn < 32) { base = w.sga; colt = (pn - 24) * 256; kind = 2; ld = DM; } else { base = w.sgb; colt = (pn - 32) * 256; kind = 2; ld = DM; }
        if (u.pm >= 64 && kind == 1) kind = 0;
        const int row0 = u.pm * BM + wr * 64 + fr, col0 = colt + wc * 32 + 8 * fq;
        const bool hi = (fq >> 1) != 0;
        const bool isq = pn < 4, isk = (pn >= 4 && pn < 8); float kmx[2] = {0.f, 0.f};
#pragma unroll
        for (int ai = 0; ai < 2; ++ai)
#pragma unroll
            for (int m = 0; m < 4; ++m) {
                const int t = row0 + ai * HALF + m * 16; bf16_t* rowp = base + (size_t)t * ld + col0;
                f32x4 cs0 = {1.f, 1.f, 1.f, 1.f}, cs1 = cs0, sn0 = {0.f, 0.f, 0.f, 0.f}, sn1 = sn0;
                if (kind == 1) { const int pos = (wc & 1) ? (t & 63) : ((t >> 6) & 255); const int o = pos * 16 + 8 * (fq & 1);
                    cs0 = *(const f32x4*)(rcos + o); cs1 = *(const f32x4*)(rcos + o + 4); sn0 = *(const f32x4*)(rsin + o); sn1 = *(const f32x4*)(rsin + o + 4);
                    if (!hi) { sn0 = -sn0; sn1 = -sn1; } }
#pragma unroll
                for (int bj = 0; bj < 2; ++bj) { f32x4 v0 = acc[ai][bj][m][0], v1 = acc[ai][bj][m][1];
                    if (kind == 1) { f32x4 p0, p1;
#pragma unroll
                        for (int j = 0; j < 4; ++j) { auto r0 = __builtin_amdgcn_permlane32_swap(__float_as_uint(v0[j]), __float_as_uint(v0[j]), false, false); p0[j] = __uint_as_float(hi ? r0[0] : r0[1]);
                            auto r1 = __builtin_amdgcn_permlane32_swap(__float_as_uint(v1[j]), __float_as_uint(v1[j]), false, false); p1[j] = __uint_as_float(hi ? r1[0] : r1[1]); }
                        v0 = v0 * cs0 + p0 * sn0; v1 = v1 * cs1 + p1 * sn1; }
                    if (isq) { v0 = v0 * QC; v1 = v1 * QC; }
                    if (isk) { float ss = (v0[0] * v0[0] + v0[1] * v0[1]) + (v0[2] * v0[2] + v0[3] * v0[3]) + (v1[0] * v1[0] + v1[1] * v1[1]) + (v1[2] * v1[2] + v1[3] * v1[3]);
                        ss += __shfl_xor(ss, 16); ss += __shfl_xor(ss, 32); kmx[bj] = fmaxf(kmx[bj], ss); }
                    if (kind == 2) {
#pragma unroll
                        for (int j = 0; j < 4; ++j) { v0[j] = fmaxf(__builtin_amdgcn_rcpf(1.0f + __expf(-v0[j])), 1e-20f); v1[j] = fmaxf(__builtin_amdgcn_rcpf(1.0f + __expf(-v1[j])), 1e-20f); } }
                    u32x4 o; o.x = cvt_pk_bf16(v0[0], v0[1]); o.y = cvt_pk_bf16(v0[2], v0[3]); o.z = cvt_pk_bf16(v1[0], v1[1]); o.w = cvt_pk_bf16(v1[2], v1[3]);
                    *(u32x4*)(rowp + bj * HALF) = o; }
            }
        if (isk) {
#pragma unroll
            for (int bj = 0; bj < 2; ++bj) { float m = kmx[bj];
                for (int o = 8; o >= 1; o >>= 1) m = fmaxf(m, __shfl_xor(m, o));
                if (fr == 0 && fq == 0) atomicMax(w.kmax + (((pn - 4) * 2 + bj) * 2 + (wc >> 1)) * 2 + (wc & 1), __float_as_uint(m)); } }
    }
};
struct EpiMerge1M {
    static constexpr bool PERM = true; static constexpr int MID_T = 16;
    const bf16_t* sga; const bf16_t* sgb; bf16_t* out;
    __device__ __forceinline__ void mid(f32x4 (&acc)[2][2][4][2], const Unit& u, int wr, int wc, int fr, int fq) const {
        asm volatile("" : "+v"(fr), "+v"(fq));
        const int row0 = u.pm * BM + wr * 64 + fr, col0 = u.pn * BM + wc * 32 + 8 * fq;
#pragma unroll
        for (int ai = 0; ai < 2; ++ai)
#pragma unroll
            for (int mp = 0; mp < 2; ++mp) { uint2 ga[2][2], gb[2][2];
#pragma unroll
                for (int mm = 0; mm < 2; ++mm) { const size_t off = (size_t)(row0 + ai * HALF + (mp * 2 + mm) * 16) * DM + col0;
#pragma unroll
                    for (int bj = 0; bj < 2; ++bj) { ga[mm][bj] = *(const uint2*)((const unsigned char*)sga + off + bj * HALF); gb[mm][bj] = *(const uint2*)((const unsigned char*)sgb + off + bj * HALF); } }
#pragma unroll
                for (int mm = 0; mm < 2; ++mm) { const int m = mp * 2 + mm;
#pragma unroll
                    for (int bj = 0; bj < 2; ++bj) { const unsigned aw[2] = {ga[mm][bj].x, ga[mm][bj].y}, bw[2] = {gb[mm][bj].x, gb[mm][bj].y};
#pragma unroll
                        for (int jj = 0; jj < 2; ++jj) { const auto a0 = __builtin_amdgcn_cvt_pk_f32_fp8((int)aw[jj], false), a1 = __builtin_amdgcn_cvt_pk_f32_fp8((int)aw[jj], true), b0 = __builtin_amdgcn_cvt_pk_f32_fp8((int)bw[jj], false), b1 = __builtin_amdgcn_cvt_pk_f32_fp8((int)bw[jj], true);
                            acc[ai][bj][m][jj][0] *= a0[0] * __builtin_amdgcn_rcpf(b0[0]); acc[ai][bj][m][jj][1] *= a0[1] * __builtin_amdgcn_rcpf(b0[1]); acc[ai][bj][m][jj][2] *= a1[0] * __builtin_amdgcn_rcpf(b1[0]); acc[ai][bj][m][jj][3] *= a1[1] * __builtin_amdgcn_rcpf(b1[1]); } } }
                asm volatile("" ::: "memory"); }
    }
    __device__ __forceinline__ void operator()(const f32x4 (&acc)[2][2][4][2], const Unit& u, int wr, int wc, int fr, int fq) const {
        asm volatile("" : "+v"(fr), "+v"(fq));
        const int row0 = u.pm * BM + wr * 64 + fr, col0 = u.pn * BM + wc * 32 + 8 * fq;
#pragma unroll
        for (int ai = 0; ai < 2; ++ai)
#pragma unroll
            for (int mp = 0; mp < 2; ++mp) { uint2 gb[2][2];
#pragma unroll
              for (int mm = 0; mm < 2; ++mm)
#pragma unroll
                for (int bj = 0; bj < 2; ++bj) gb[mm][bj] = *(const uint2*)((const unsigned char*)sgb + (size_t)(row0 + ai * HALF + (mp * 2 + mm) * 16) * DM + col0 + bj * HALF);
#pragma unroll
              for (int mm = 0; mm < 2; ++mm) { const int m = mp * 2 + mm; const size_t off = (size_t)(row0 + ai * HALF + m * 16) * DM + col0;
#pragma unroll
                for (int bj = 0; bj < 2; ++bj) { const uint2 b = gb[mm][bj]; const unsigned bw[2] = {b.x, b.y};
                    const f32x4 v0 = acc[ai][bj][m][0], v1 = acc[ai][bj][m][1]; float r[8];
#pragma unroll
                    for (int jj = 0; jj < 2; ++jj) { const auto b0 = __builtin_amdgcn_cvt_pk_f32_fp8((int)bw[jj], false), b1 = __builtin_amdgcn_cvt_pk_f32_fp8((int)bw[jj], true); const f32x4& v = jj ? v1 : v0; r[4 * jj] = v[0] * b0[0]; r[4 * jj + 1] = v[1] * b0[1]; r[4 * jj + 2] = v[2] * b1[0]; r[4 * jj + 3] = v[3] * b1[1]; }
                    u32x4 o; o.x = cvt_pk_bf16(r[0], r[1]); o.y = cvt_pk_bf16(r[2], r[3]); o.z = cvt_pk_bf16(r[4], r[5]); o.w = cvt_pk_bf16(r[6], r[7]);
                    *(u32x4*)(out + off + bj * HALF) = o; } }
                asm volatile("" ::: "memory"); }
    }
};
struct EpiResidM {
    static constexpr bool PERM = false; static constexpr int MID_T = 0;
    const float* x; const float* gt; float* out;
    __device__ __forceinline__ void operator()(const f32x4 (&acc)[2][2][4][2], const Unit& u, int wr, int wc, int fr, int fq) const {
        asm volatile("" : "+v"(fr), "+v"(fq));
        const int row0 = u.pm * BM + wr * 64 + fr, col0 = u.pn * BM + wc * 32 + 4 * fq;
        f32x4 gv[2][2];
#pragma unroll
        for (int bj = 0; bj < 2; ++bj)
#pragma unroll
            for (int n = 0; n < 2; ++n) gv[bj][n] = *(const f32x4*)(gt + col0 + bj * HALF + n * 16);
#pragma unroll
        for (int ai = 0; ai < 2; ++ai)
#pragma unroll
            for (int mp = 0; mp < 2; ++mp) { f32x4 xv[2][2][2];
#pragma unroll
              for (int mm = 0; mm < 2; ++mm) { const size_t off = (size_t)(row0 + ai * HALF + (mp * 2 + mm) * 16) * DM + col0;
#pragma unroll
                for (int bj = 0; bj < 2; ++bj)
#pragma unroll
                    for (int n = 0; n < 2; ++n) xv[mm][bj][n] = *(const f32x4*)(x + off + bj * HALF + n * 16); }
#pragma unroll
              for (int mm = 0; mm < 2; ++mm) { const int m = mp * 2 + mm; const size_t off = (size_t)(row0 + ai * HALF + m * 16) * DM + col0;
#pragma unroll
                for (int bj = 0; bj < 2; ++bj)
#pragma unroll
                    for (int n = 0; n < 2; ++n) *(f32x4*)(out + off + bj * HALF + n * 16) = xv[mm][bj][n] + gv[bj][n] * acc[ai][bj][m][n]; }
                asm volatile("" ::: "memory"); }
    }
};
struct EpiBf16M {
    static constexpr bool PERM = true; static constexpr int MID_T = 0;
    bf16_t* out; int ld;
    __device__ __forceinline__ void operator()(const f32x4 (&acc)[2][2][4][2], const Unit& u, int wr, int wc, int fr, int fq) const {
        asm volatile("" : "+v"(fr), "+v"(fq));
        const int row0 = u.pm * BM + wr * 64 + fr, col0 = u.pn * BM + wc * 32 + 8 * fq;
#pragma unroll
        for (int ai = 0; ai < 2; ++ai)
#pragma unroll
            for (int m = 0; m < 4; ++m) { bf16_t* rowp = out + (size_t)(row0 + ai * HALF + m * 16) * ld + col0;
#pragma unroll
                for (int bj = 0; bj < 2; ++bj) { const f32x4 v0 = acc[ai][bj][m][0], v1 = acc[ai][bj][m][1];
                    u32x4 o; o.x = cvt_pk_bf16(v0[0], v0[1]); o.y = cvt_pk_bf16(v0[2], v0[3]); o.z = cvt_pk_bf16(v1[0], v1[1]); o.w = cvt_pk_bf16(v1[2], v1[3]);
                    *(u32x4*)(rowp + bj * HALF) = o; } }
    }
};
template <class Epi, class Sched>
__device__ __forceinline__ void gemm_phase8(PG8_LAS unsigned char* lds, const Gemm g, const Sched& S, const Epi& E) {
    int tid = threadIdx.x; asm volatile("" : "+v"(tid));
    const int wid = __builtin_amdgcn_readfirstlane(tid >> 6), lane = tid & 63, wr = wid >> 2, wc = wid & 3, fr = lane & 15, fq = lane >> 4;
    const int K = g.K / 2, nt = K / BK;
    unsigned voffA[2], voffB[2];
#pragma unroll
    for (int i = 0; i < 2; ++i) { int R, C; stage_rc(tid * 16 + i * 8192, R, C); const int Rb = (R & ~31) + perm32f8(R & 31);
        voffA[i] = (unsigned)(R * K + C) * 2u; voffB[i] = (unsigned)(Rb * K + C) * 2u; }
    const size_t kstep = (size_t)(BK * 2);
    const size_t hstep = (size_t)HALF * K * 2;
    const size_t tstep = 2 * hstep;
    const unsigned ldsw = (unsigned)wid * 1024u;
    const int r32 = lane & 31, hi = lane >> 5; (void)fr; (void)fq;
    const int aoff = lds_byte(wr * 64 + r32, hi * 16), boff = lds_byte(wc * 32 + r32, hi * 16);
#define PG8_SA(b, h) (((b) * 2 + (h)) * HTB)
#define PG8_SB(b, h) ((4 + (b) * 2 + (h)) * HTB)
#define PG8_STAGE(bufoff, gbase, voff) do { _Pragma("unroll") for (int _i = 0; _i < 2; ++_i) \
        __builtin_amdgcn_global_load_lds((const unsigned*)((const char*)(gbase) + (voff)[_i]), (PG8_LAS unsigned*)(lds + (bufoff) + ldsw + _i * 8192), 16, 0, 0); } while (0)
#define PG8_LD32(off) ({ const i32x4 lo_ = *(const PG8_LAS i32x4*)(lds + (off)), hi_ = *(const PG8_LAS i32x4*)(lds + (off) + 16); (i32x8){lo_[0], lo_[1], lo_[2], lo_[3], hi_[0], hi_[1], hi_[2], hi_[3]}; })
#define PG8_LDA(dst, b, h) do { _Pragma("unroll") for (int m = 0; m < 2; ++m) _Pragma("unroll") for (int k = 0; k < 2; ++k) dst[m][k] = PG8_LD32(PG8_SA(b, h) + aoff + m * 4096 + k * 1024); } while (0)
#define PG8_LDB(dst, b, h) do { _Pragma("unroll") for (int k = 0; k < 2; ++k) dst[k] = PG8_LD32(PG8_SB(b, h) + boff + k * 1024); } while (0)
#define PG8_MMA(ai, bj, At, Bt) do { __builtin_amdgcn_s_setprio(1); _Pragma("unroll") for (int m = 0; m < 2; ++m) _Pragma("unroll") for (int k = 0; k < 2; ++k) \
        acc[ai][bj][m] = __builtin_amdgcn_mfma_scale_f32_32x32x64_f8f6f4(Bt[k], At[m][k], acc[ai][bj][m], 0, 0, 0, 0x7f7f7f7f, 0, 0x7f7f7f7f); __builtin_amdgcn_s_setprio(0); } while (0)
#define PG8_WAIT_V(n) asm volatile("s_waitcnt vmcnt(" #n ")" ::: "memory")
#define PG8_WAIT_L(n) asm volatile("s_waitcnt lgkmcnt(" #n ")" ::: "memory")
#define PG8_BAR __builtin_amdgcn_s_barrier()
#define PG8_SCHED __builtin_amdgcn_sched_barrier(0)
#define PG8_KBODY \
            const bool last = (t == nt - 2); \
            const char* a1 = cA + (size_t)(t + 1) * kstep; \
            const char* a2 = last ? nA : cA + (size_t)(t + 2) * kstep; const char* b2 = last ? nB : cB + (size_t)(t + 2) * kstep; \
            const char* a3 = a2 + kstep; const char* b3 = b2 + kstep; \
            PG8_LDB(B0, 0, 0); PG8_SCHED; PG8_LDA(At, 0, 0); PG8_STAGE(PG8_SA(1, 1), a1 + hstep, voffA); \
            PG8_WAIT_L(8); PG8_BAR; PG8_WAIT_L(0); PG8_MMA(0, 0, At, B0); PG8_BAR; PG8_SCHED; \
            PG8_LDB(B1, 0, 1); PG8_STAGE(PG8_SB(0, 0), b2, voffB); \
            PG8_BAR; PG8_WAIT_L(0); PG8_MMA(0, 1, At, B1); PG8_BAR; \
            PG8_LDA(At, 0, 1); PG8_STAGE(PG8_SA(0, 0), a2, voffA); \
            PG8_BAR; PG8_WAIT_L(0); PG8_MMA(1, 0, At, B0); PG8_BAR; PG8_SCHED; \
            PG8_STAGE(PG8_SB(0, 1), b2 + hstep, voffB); \
            PG8_WAIT_V(6); PG8_BAR; PG8_MMA(1, 1, At, B1); PG8_BAR; \
            PG8_LDB(B0, 1, 0); PG8_SCHED; PG8_LDA(At, 1, 0); PG8_STAGE(PG8_SA(0, 1), a2 + hstep, voffA); \
            PG8_WAIT_L(8); PG8_BAR; PG8_WAIT_L(0); PG8_MMA(0, 0, At, B0); PG8_BAR; PG8_SCHED; \
            PG8_LDB(B1, 1, 1); PG8_STAGE(PG8_SB(1, 0), b3, voffB); \
            PG8_BAR; PG8_WAIT_L(0); PG8_MMA(0, 1, At, B1); PG8_BAR; \
            PG8_LDA(At, 1, 1); PG8_STAGE(PG8_SA(1, 0), a3, voffA); \
            PG8_BAR; PG8_WAIT_L(0); PG8_MMA(1, 0, At, B0); PG8_BAR; PG8_SCHED; \
            PG8_STAGE(PG8_SB(1, 1), b3 + hstep, voffB); \
            PG8_WAIT_V(6); PG8_BAR; PG8_MMA(1, 1, At, B1); PG8_BAR;
    Unit cur, nxt; int ui = 0;
    if (!S.next(0, cur)) return;
    f32x16 acc[2][2][2];
#pragma unroll
    for (int a = 0; a < 2; ++a)
#pragma unroll
        for (int b = 0; b < 2; ++b)
#pragma unroll
            for (int m = 0; m < 2; ++m) acc[a][b][m] = f32x16{};
    i32x8 At[2][2], B0[2], B1[2];
    const char* cA = (const char*)g.A + (size_t)cur.pm * tstep; const char* cB = (const char*)g.Bt + (size_t)cur.pn * tstep;
    PG8_STAGE(PG8_SB(0, 0), cB, voffB); PG8_STAGE(PG8_SA(0, 0), cA, voffA); PG8_STAGE(PG8_SB(0, 1), cB + hstep, voffB); PG8_STAGE(PG8_SA(0, 1), cA + hstep, voffA);
    if (wr == 1) PG8_BAR;
    PG8_WAIT_V(4); PG8_BAR;
    PG8_STAGE(PG8_SB(1, 0), cB + kstep, voffB); PG8_STAGE(PG8_SA(1, 0), cA + kstep, voffA); PG8_STAGE(PG8_SB(1, 1), cB + hstep + kstep, voffB);
    PG8_WAIT_V(6); PG8_BAR;
    for (;;) {
        const bool has_next = S.next(ui + 1, nxt);
        const char* nA = has_next ? (const char*)g.A + (size_t)nxt.pm * tstep : cA; const char* nB = has_next ? (const char*)g.Bt + (size_t)nxt.pn * tstep : cB;
        if constexpr (Epi::MID_T > 0) {
            for (int t = 0; t < Epi::MID_T; t += 2) { PG8_KBODY }
            E.mid(acc, cur, wr, wc, r32, hi);
            for (int t = Epi::MID_T; t < nt; t += 2) { PG8_KBODY }
        } else {
            for (int t = 0; t < nt; t += 2) { PG8_KBODY }
        }
        E(acc, cur, wr, wc, r32, hi);
        if (!has_next) break;
#pragma unroll
        for (int a = 0; a < 2; ++a)
#pragma unroll
            for (int b = 0; b < 2; ++b)
#pragma unroll
                for (int m = 0; m < 2; ++m) acc[a][b][m] = f32x16{};
        cur = nxt; cA = nA; cB = nB; ++ui;
    }
    PG8_WAIT_V(0);
    if (wr == 0) PG8_BAR;
    PG8_BAR;
#undef PG8_KBODY
#undef PG8_SA
#undef PG8_SB
#undef PG8_STAGE
#undef PG8_LD32
#undef PG8_LDA
#undef PG8_LDB
#undef PG8_MMA
#undef PG8_WAIT_V
#undef PG8_WAIT_L
#undef PG8_BAR
#undef PG8_SCHED
}


constexpr float WSC = 1.0f / 64.0f;
struct EpiInProj8 {
    static constexpr int MID_T = 0; static constexpr bool PERM = true;
    WS w; const float* rcos; const float* rsin;
    static constexpr float QC = 0.125f * 1.4426950408889634f, QCB = 0.08838834764831845f * 1.4426950408889634f;
    __device__ __forceinline__ void operator()(const f32x16 (&acc)[2][2][2], const Unit& u, int wr, int wc, int r32, int hi) const {
        asm volatile("" : "+v"(r32), "+v"(hi));
        const int pn = u.pn; bf16_t* base; int ld = 1024, colt; int kind;
        if (pn < 4) { base = w.qa; colt = pn * 256; kind = 1; } else if (pn < 8) { base = w.ka; colt = (pn - 4) * 256; kind = 1; }
        else if (pn < 12) { base = w.va; colt = (pn - 8) * 256; kind = 0; } else if (pn < 16) { base = w.qb; colt = (pn - 12) * 256; kind = 0; }
        else if (pn < 20) { base = w.kb; colt = (pn - 16) * 256; kind = 0; } else if (pn < 24) { base = w.vb; colt = (pn - 20) * 256; kind = 0; }
        else if (pn < 32) { base = w.sga; colt = (pn - 24) * 256; kind = 2; ld = DM; } else { base = w.sgb; colt = (pn - 32) * 256; kind = 2; ld = DM; }
        if (u.pm >= 64 && kind == 1) kind = 0;
        const bool isb = pn >= 12 && pn < 24; const int pq = isb ? pn - 12 : pn;
        const bool isq = pq < 4, isk = (pq >= 4 && pq < 8), isv = (pq >= 8 && pq < 12); float kmx[2] = {0.f, 0.f};
        const int row0 = u.pm * BM + wr * 64 + r32, col0 = colt + wc * 32 + 16 * hi;
#pragma unroll
        for (int ai = 0; ai < 2; ++ai)
#pragma unroll
            for (int m = 0; m < 2; ++m) {
                const int t = row0 + ai * HALF + m * 32; bf16_t* rowp = base + (size_t)t * ld + col0;
                float cs[16], sn[16];
                if (kind == 1) { const int pos = (wc & 1) ? (t & 63) : ((t >> 6) & 255);
#pragma unroll
                    for (int q = 0; q < 4; ++q) { const f32x4 c4 = *(const f32x4*)(rcos + pos * 16 + q * 4), s4 = *(const f32x4*)(rsin + pos * 16 + q * 4);
#pragma unroll
                        for (int j = 0; j < 4; ++j) { cs[q * 4 + j] = c4[j]; sn[q * 4 + j] = hi ? s4[j] : -s4[j]; } } }
#pragma unroll
                for (int bj = 0; bj < 2; ++bj) { float v[16];
#pragma unroll
                    for (int r = 0; r < 16; ++r) v[r] = acc[ai][bj][m][r] * WSC;
                    if (kind == 1) {
#pragma unroll
                        for (int r = 0; r < 16; ++r) { auto rr = __builtin_amdgcn_permlane32_swap(__float_as_uint(v[r]), __float_as_uint(v[r]), false, false); const float pv = __uint_as_float(hi ? rr[0] : rr[1]); v[r] = v[r] * cs[r] + pv * sn[r]; } }
                    if (isq) {
#pragma unroll
                        for (int r = 0; r < 16; ++r) v[r] *= (isb ? QCB : QC) * 4.0f; }
                    if (isk) { float ss = 0.f;
#pragma unroll
                        for (int r = 0; r < 16; ++r) v[r] *= 0.25f;
#pragma unroll
                        for (int r = 0; r < 16; ++r) ss += v[r] * v[r];
                        { auto rr = __builtin_amdgcn_permlane32_swap(__float_as_uint(ss), __float_as_uint(ss), false, false); ss = __uint_as_float(rr[0]) + __uint_as_float(rr[1]); }
                        kmx[bj] = fmaxf(kmx[bj], ss); }
                    if (kind == 2) {
#pragma unroll
                        for (int r = 0; r < 16; ++r) v[r] = fmaxf(__builtin_amdgcn_rcpf(1.0f + __expf(-v[r])), 0.001953125f);
                        int pk[4] = {0, 0, 0, 0};
#pragma unroll
                        for (int q4 = 0; q4 < 4; ++q4) { pk[q4] = __builtin_amdgcn_cvt_pk_fp8_f32(v[q4 * 4], v[q4 * 4 + 1], pk[q4], false); pk[q4] = __builtin_amdgcn_cvt_pk_fp8_f32(v[q4 * 4 + 2], v[q4 * 4 + 3], pk[q4], true); }
                        *(u32x4*)((unsigned char*)base + (size_t)t * DM + col0 + bj * HALF) = (u32x4){(unsigned)pk[0], (unsigned)pk[1], (unsigned)pk[2], (unsigned)pk[3]};
                        continue; }
                    if (isv) {
                        const int k = t & 63, kk = k & 31, pos = 32 * ((kk >> 2) & 1) + 16 * (k >> 5) + (kk & 3) + 4 * (kk >> 3);
                        unsigned char* vp = (unsigned char*)(isb ? w.vb : w.va) + ((size_t)(((pq - 8) * 2 + bj) * 128 + wc * 32 + 16 * hi)) * TOT + (size_t)(t >> 6) * 64 + pos;
#pragma unroll
                        for (int q4 = 0; q4 < 4; ++q4) { int pk = 0; pk = __builtin_amdgcn_cvt_pk_fp8_f32(v[q4 * 4], v[q4 * 4 + 1], pk, false); pk = __builtin_amdgcn_cvt_pk_fp8_f32(v[q4 * 4 + 2], v[q4 * 4 + 3], pk, true);
                            vp[(size_t)(q4 * 4 + 0) * TOT] = (unsigned char)pk; vp[(size_t)(q4 * 4 + 1) * TOT] = (unsigned char)(pk >> 8); vp[(size_t)(q4 * 4 + 2) * TOT] = (unsigned char)(pk >> 16); vp[(size_t)(q4 * 4 + 3) * TOT] = (unsigned char)(pk >> 24); }
                    } else if (isq || isk) { int pk[4] = {0, 0, 0, 0};
#pragma unroll
                        for (int q4 = 0; q4 < 4; ++q4) { pk[q4] = __builtin_amdgcn_cvt_pk_fp8_f32(v[q4 * 4], v[q4 * 4 + 1], pk[q4], false); pk[q4] = __builtin_amdgcn_cvt_pk_fp8_f32(v[q4 * 4 + 2], v[q4 * 4 + 3], pk[q4], true); }
                        *(u32x4*)((unsigned char*)base + (size_t)t * 1024 + col0 + bj * HALF) = (u32x4){(unsigned)pk[0], (unsigned)pk[1], (unsigned)pk[2], (unsigned)pk[3]};
                    } else {
                    u32x4 o0, o1;
                    o0.x = cvt_pk_bf16(v[0], v[1]); o0.y = cvt_pk_bf16(v[2], v[3]); o0.z = cvt_pk_bf16(v[4], v[5]); o0.w = cvt_pk_bf16(v[6], v[7]);
                    o1.x = cvt_pk_bf16(v[8], v[9]); o1.y = cvt_pk_bf16(v[10], v[11]); o1.z = cvt_pk_bf16(v[12], v[13]); o1.w = cvt_pk_bf16(v[14], v[15]);
                    *(u32x4*)(rowp + bj * HALF) = o0; *(u32x4*)(rowp + bj * HALF + 8) = o1; } }
            }
        if (isk && !isb) {
#pragma unroll
            for (int bj = 0; bj < 2; ++bj) { float mm = kmx[bj];
                for (int o = 16; o >= 1; o >>= 1) mm = fmaxf(mm, __shfl_xor(mm, o));
                if (r32 == 0 && hi == 0) atomicMax(w.kmax + (((pn - 4) * 2 + bj) * 2 + (wc >> 1)) * 2 + (wc & 1), __float_as_uint(mm)); } }
    }
};
}

__device__ __forceinline__ void prep_transpose(int tile, char* lds, const float* __restrict__ W, int ldn, int K, int N, bf16_t* Wt, int ldk, int koff) {
  float (*T)[129] = (float (*)[129])lds;
  int tid = threadIdx.x; asm volatile("" : "+v"(tid));
  const int ntn = N / 128, tk = tile / ntn, tn = tile % ntn, k0 = tk * 64, n0 = tn * 128;
  __syncthreads();
#pragma unroll
  for (int i = 0; i < 4; ++i) { const int e = tid + i * 512, r = e >> 5, c4 = (e & 31) * 4; const float4 v = *(const float4*)(W + (size_t)(k0 + r) * ldn + n0 + c4);
    T[r][c4] = v.x; T[r][c4 + 1] = v.y; T[r][c4 + 2] = v.z; T[r][c4 + 3] = v.w; }
  __syncthreads();
#pragma unroll
  for (int i = 0; i < 2; ++i) { const int e = tid + i * 512, n = e >> 3, k8 = (e & 7) * 8; pg8::u32x4 o;
    o.x = pg8::cvt_pk_bf16(T[k8][n], T[k8 + 1][n]); o.y = pg8::cvt_pk_bf16(T[k8 + 2][n], T[k8 + 3][n]); o.z = pg8::cvt_pk_bf16(T[k8 + 4][n], T[k8 + 5][n]); o.w = pg8::cvt_pk_bf16(T[k8 + 6][n], T[k8 + 7][n]);
    *(pg8::u32x4*)(Wt + (size_t)(n0 + n) * ldk + koff + k0 + k8) = o; }
}

__device__ __forceinline__ void prep_transpose8(int tile, char* lds, const float* __restrict__ W, int ldn, int K, int N, unsigned char* Wt, int ldk, int koff) {
  float (*T)[129] = (float (*)[129])lds;
  int tid = threadIdx.x; asm volatile("" : "+v"(tid));
  const int ntn = N / 128, tk = tile / ntn, tn = tile % ntn, k0 = tk * 64, n0 = tn * 128;
  __syncthreads();
#pragma unroll
  for (int i = 0; i < 4; ++i) { const int e = tid + i * 512, r = e >> 5, c4 = (e & 31) * 4; const float4 v = *(const float4*)(W + (size_t)(k0 + r) * ldn + n0 + c4);
    T[r][c4] = v.x * 64.0f; T[r][c4 + 1] = v.y * 64.0f; T[r][c4 + 2] = v.z * 64.0f; T[r][c4 + 3] = v.w * 64.0f; }
  __syncthreads();
#pragma unroll
  for (int i = 0; i < 2; ++i) { const int e = tid + i * 512, n = e >> 3, k8 = (e & 7) * 8; int a = 0, b = 0;
    a = __builtin_amdgcn_cvt_pk_fp8_f32(T[k8][n], T[k8 + 1][n], a, false); a = __builtin_amdgcn_cvt_pk_fp8_f32(T[k8 + 2][n], T[k8 + 3][n], a, true);
    b = __builtin_amdgcn_cvt_pk_fp8_f32(T[k8 + 4][n], T[k8 + 5][n], b, false); b = __builtin_amdgcn_cvt_pk_fp8_f32(T[k8 + 6][n], T[k8 + 7][n], b, true);
    *(uint2*)(Wt + (size_t)(n0 + n) * ldk + koff + k0 + k8) = make_uint2((unsigned)a, (unsigned)b); }
}

namespace at {
typedef short bf16x8 __attribute__((ext_vector_type(8)));
typedef short s16x4 __attribute__((ext_vector_type(4)));
typedef float f32x16 __attribute__((ext_vector_type(16)));
typedef unsigned u32x4 __attribute__((ext_vector_type(4)));
constexpr int NW = 8, QBLK = 32, KVBLK = 64, LDQ = 1024, LDK = 1024;
constexpr int SHM_V = 16384, SHM_K = 16384, OFF_K = 2 * SHM_V, OFF_WS = 2 * SHM_V + 2 * SHM_K, OFF_STASH = OFF_WS + NW * 64 * 4, STASH_BYTES = 256 * 128 * 2, OFF_END = OFF_STASH + STASH_BYTES;
constexpr float LOG2E = 1.4426950408889634f;
#define AT_KSWZ(row, colB) ((row) * 256 + ((colB) ^ (((row) & 7) << 4)))
#define AT_SBAR() __builtin_amdgcn_sched_barrier(0)
__device__ __forceinline__ int crow(int r, int hi) { return (r & 3) + 8 * (r >> 2) + 4 * hi; }
__device__ __forceinline__ unsigned cvtpk(float lo, float hi) { unsigned r; asm volatile("v_cvt_pk_bf16_f32 %0, %1, %2" : "=v"(r) : "v"(lo), "v"(hi)); return r; }

template <class Hook>
__device__ __forceinline__ void partialSM(f32x16& p0, f32x16& p1, float& m_reg, float& mn, float& alpha) {
  constexpr float C = Hook::SCALE * LOG2E, THRS = 8.0f / Hook::SCALE;
  float pmax = p0[0];
#pragma unroll
  for (int r = 1; r < 16; ++r) pmax = fmaxf(pmax, p0[r]);
#pragma unroll
  for (int r = 0; r < 16; ++r) pmax = fmaxf(pmax, p1[r]);
  { auto rr = __builtin_amdgcn_permlane32_swap(__float_as_uint(pmax), __float_as_uint(pmax), false, false); pmax = fmaxf(__uint_as_float(rr[0]), __uint_as_float(rr[1])); }
  if (__builtin_expect(__all(pmax - m_reg <= THRS), 1)) { mn = m_reg; alpha = 1.f; }
  else { mn = fmaxf(m_reg, pmax); alpha = __builtin_amdgcn_exp2f((m_reg - mn) * C); m_reg = mn; }
  const float mnC = -mn * C;
#pragma unroll
  for (int r = 0; r < 16; ++r) p0[r] = fmaf(p0[r], C, mnC);
#pragma unroll
  for (int r = 0; r < 16; ++r) p1[r] = fmaf(p1[r], C, mnC);
#pragma unroll
  for (int r = 0; r < 16; ++r) p0[r] = __builtin_amdgcn_exp2f(p0[r]);
}
__device__ __forceinline__ void finishSM(f32x16& p0, f32x16& p1, float alpha, float& l_reg, bf16x8& pa0, bf16x8& pa1, bf16x8& pa2, bf16x8& pa3) {
#pragma unroll
  for (int r = 0; r < 16; ++r) p1[r] = __builtin_amdgcn_exp2f(p1[r]);
  float ps = 0;
#pragma unroll
  for (int r = 0; r < 16; ++r) ps += p0[r];
#pragma unroll
  for (int r = 0; r < 16; ++r) ps += p1[r];
  { auto rr = __builtin_amdgcn_permlane32_swap(__float_as_uint(ps), __float_as_uint(ps), false, false); ps = __uint_as_float(rr[0]) + __uint_as_float(rr[1]); }
  l_reg = l_reg * alpha + ps;
#define AT_PK4(P, BASE, OUT) do { unsigned a0 = cvtpk(P[BASE + 0], P[BASE + 1]), a1 = cvtpk(P[BASE + 2], P[BASE + 3]);   \
    unsigned b0 = cvtpk(P[BASE + 4], P[BASE + 5]), b1 = cvtpk(P[BASE + 6], P[BASE + 7]);                              \
    auto r0 = __builtin_amdgcn_permlane32_swap(a0, b0, false, false); auto r1 = __builtin_amdgcn_permlane32_swap(a1, b1, false, false); \
    u32x4 w = {r0[0], r1[0], r0[1], r1[1]}; OUT = *reinterpret_cast<bf16x8*>(&w); } while (0)
  AT_PK4(p0, 0, pa0); AT_PK4(p0, 8, pa1); AT_PK4(p1, 0, pa2); AT_PK4(p1, 8, pa3);
#undef AT_PK4
}
template <int ND0>
__device__ __forceinline__ void qkt(f32x16& p0, f32x16& p1, const char* Ks, const bf16x8* qr, int r32, int hi, int kcolB) {
#pragma unroll
  for (int d0 = 0; d0 < ND0; ++d0) { const int cb = kcolB + (d0 * 16 + hi * 8) * 2;
    const bf16x8 b0 = *reinterpret_cast<const bf16x8*>(Ks + AT_KSWZ(r32, cb));
    const bf16x8 b1 = *reinterpret_cast<const bf16x8*>(Ks + AT_KSWZ(32 + r32, cb));
    p0 = __builtin_amdgcn_mfma_f32_32x32x16_bf16(b0, qr[d0], p0, 0, 0, 0);
    p1 = __builtin_amdgcn_mfma_f32_32x32x16_bf16(b1, qr[d0], p1, 0, 0, 0); }
}
__device__ __forceinline__ int v_st(int k, int c) { const int kk = (k & ~0xC) | ((k & 4) << 1) | ((k & 8) >> 1); return ((kk >> 3) * 4 + (c >> 5)) * 512 + ((kk & 7) * 32 + (c & 31)) * 2; }
__device__ __forceinline__ int v_rd_base(int lane) { return ((lane & 3) << 3) | (((lane >> 2) & 3) << 6) | (((lane >> 4) & 1) << 5) | (((lane >> 5) & 1) << 8); }
constexpr int v_rd_off(int d0, int ks, int half) { return d0 * 512 + ks * 4096 + half * 2048; }
template <int OFF> __device__ __forceinline__ s16x4 tr_read(int vb) { s16x4 r; asm volatile("ds_read_b64_tr_b16 %0, %1 offset:%2" : "=&v"(r) : "v"(vb), "i"(OFF) : "memory"); return r; }
template <int D0> __device__ __forceinline__ void pv_one(f32x16& od, int vb, bf16x8 pa0, bf16x8 pa1, bf16x8 pa2, bf16x8 pa3) {
  const s16x4 l0 = tr_read<v_rd_off(D0, 0, 0)>(vb), h0 = tr_read<v_rd_off(D0, 0, 1)>(vb), l1 = tr_read<v_rd_off(D0, 1, 0)>(vb), h1 = tr_read<v_rd_off(D0, 1, 1)>(vb);
  const s16x4 l2 = tr_read<v_rd_off(D0, 2, 0)>(vb), h2 = tr_read<v_rd_off(D0, 2, 1)>(vb), l3 = tr_read<v_rd_off(D0, 3, 0)>(vb), h3 = tr_read<v_rd_off(D0, 3, 1)>(vb);
  asm volatile("s_waitcnt lgkmcnt(0)" ::: "memory"); AT_SBAR();
#define AT_PK(L, H) (bf16x8){L[0], L[1], L[2], L[3], H[0], H[1], H[2], H[3]}
  od = __builtin_amdgcn_mfma_f32_32x32x16_bf16(pa0, AT_PK(l0, h0), od, 0, 0, 0);
  od = __builtin_amdgcn_mfma_f32_32x32x16_bf16(pa1, AT_PK(l1, h1), od, 0, 0, 0);
  od = __builtin_amdgcn_mfma_f32_32x32x16_bf16(pa2, AT_PK(l2, h2), od, 0, 0, 0);
  od = __builtin_amdgcn_mfma_f32_32x32x16_bf16(pa3, AT_PK(l3, h3), od, 0, 0, 0);
#undef AT_PK
}
__device__ __forceinline__ void pv_d0(f32x16* o, int vb, bf16x8 pa0, bf16x8 pa1, bf16x8 pa2, bf16x8 pa3) {
  pv_one<0>(o[0], vb, pa0, pa1, pa2, pa3); pv_one<1>(o[1], vb, pa0, pa1, pa2, pa3); pv_one<2>(o[2], vb, pa0, pa1, pa2, pa3); pv_one<3>(o[3], vb, pa0, pa1, pa2, pa3);
}

template <int ND0, class Hook>
__device__ __forceinline__ void attn_pass(const bf16_t* __restrict__ Qb, const bf16_t* __restrict__ Kh, const bf16_t* __restrict__ Vh, int NT, int kcolB, const Hook& H, char* lds, f32x16 (&o)[4], float& l_out) {
  int tid = threadIdx.x; asm volatile("" : "+v"(tid));
  const int wid = __builtin_amdgcn_readfirstlane(tid >> 6), lane = tid & 63, r32 = lane & 31, hi = lane >> 5;
  char* V_lds = lds; char* K_lds = lds + OFF_K;
  float* ws = (float*)(lds + OFF_WS) + wid * 64; float* al_l = ws + 32;
  float m_reg = -1e30f, l_reg = 0; bf16x8 qr[ND0];
#pragma unroll
  for (int d = 0; d < 4; ++d) o[d] = f32x16{};
  const bf16_t* Qw = Qb + (long)(wid * QBLK + r32) * LDQ + hi * 8;
#pragma unroll
  for (int d0 = 0; d0 < ND0; ++d0) qr[d0] = *reinterpret_cast<const bf16x8*>(Qw + d0 * 16);
  const int sr = tid >> 4, sc = (tid & 15) * 8, vst0 = v_st(sr, sc), vst1 = v_st(32 + sr, sc);
  const int vb0 = (int)(uintptr_t)V_lds + v_rd_base(lane);
  struct { bf16x8 vs0, vs1, ks0, ks1; } sr_[2];
#define AT_SLOAD(i, jj) do { const long k0_ = H.krow(jj); sr_[i].vs0 = *(const bf16x8*)(&Vh[(k0_ + sr) * LDK + sc]); sr_[i].vs1 = *(const bf16x8*)(&Vh[(k0_ + 32 + sr) * LDK + sc]); \
    sr_[i].ks0 = *(const bf16x8*)(&Kh[(k0_ + sr) * LDK + sc]); sr_[i].ks1 = *(const bf16x8*)(&Kh[(k0_ + 32 + sr) * LDK + sc]); } while (0)
#define AT_SWRITE(b, i) do { *(bf16x8*)(V_lds + (b) * SHM_V + vst0) = sr_[i].vs0; *(bf16x8*)(V_lds + (b) * SHM_V + vst1) = sr_[i].vs1; const int kc = sc * 2; \
    *(bf16x8*)(K_lds + (b) * SHM_K + AT_KSWZ(sr, kc)) = sr_[i].ks0; *(bf16x8*)(K_lds + (b) * SHM_K + AT_KSWZ(32 + sr, kc)) = sr_[i].ks1; } while (0)
#define AT_SWAIT() asm volatile("s_waitcnt vmcnt(4)" ::: "memory")
#define AT_RESC(a) do { if (__any((a) < 1.f)) { if (hi == 0) al_l[r32] = (a); asm volatile("s_waitcnt lgkmcnt(0)" ::: "memory"); \
    _Pragma("unroll") for (int d = 0; d < 4; ++d) _Pragma("unroll") for (int r = 0; r < 16; ++r) o[d][r] *= al_l[crow(r, hi)]; } } while (0)
  f32x16 pA0, pA1, pB0, pB1; float mnA, mnB, alA, alB; bf16x8 pa0, pa1, pa2, pa3;
  __syncthreads();
  AT_SLOAD(0, 0); asm volatile("s_waitcnt vmcnt(0)" ::: "memory"); AT_SWRITE(0, 0); __syncthreads();
  H.init(pA0, pA1, 0, wid, r32, hi); if (!H.skip(0, wid)) qkt<ND0>(pA0, pA1, K_lds, qr, r32, hi, kcolB); partialSM<Hook>(pA0, pA1, m_reg, mnA, alA);
  AT_SLOAD(1, 1); if (2 < NT) AT_SLOAD(0, 2);
  AT_SWAIT(); AT_SWRITE(1, 1); __syncthreads();
  for (int j = 1; j + 1 < NT; j += 2) {
    AT_SBAR(); H.init(pB0, pB1, j, wid, r32, hi); if (!H.skip(j, wid)) qkt<ND0>(pB0, pB1, K_lds + SHM_K, qr, r32, hi, kcolB);
    finishSM(pA0, pA1, alA, l_reg, pa0, pa1, pa2, pa3); AT_SBAR();
    AT_SLOAD(1, j + 2); AT_SBAR();
    if (!H.skip(j - 1, wid)) pv_d0(o, vb0, pa0, pa1, pa2, pa3); partialSM<Hook>(pB0, pB1, m_reg, mnB, alB);
    __syncthreads(); AT_SWAIT(); AT_SWRITE(0, 0);
    AT_RESC(alB); __syncthreads();
    AT_SBAR(); H.init(pA0, pA1, j + 1, wid, r32, hi); if (!H.skip(j + 1, wid)) qkt<ND0>(pA0, pA1, K_lds, qr, r32, hi, kcolB);
    finishSM(pB0, pB1, alB, l_reg, pa0, pa1, pa2, pa3); AT_SBAR();
    if (j + 3 < NT) AT_SLOAD(0, j + 3); AT_SBAR();
    if (!H.skip(j, wid)) pv_d0(o, vb0 + SHM_V, pa0, pa1, pa2, pa3); partialSM<Hook>(pA0, pA1, m_reg, mnA, alA);
    __syncthreads(); AT_SWAIT(); AT_SWRITE(1, 1);
    AT_RESC(alA); __syncthreads();
  }
  AT_SBAR(); H.init(pB0, pB1, NT - 1, wid, r32, hi); if (!H.skip(NT - 1, wid)) qkt<ND0>(pB0, pB1, K_lds + SHM_K, qr, r32, hi, kcolB);
  finishSM(pA0, pA1, alA, l_reg, pa0, pa1, pa2, pa3); AT_SBAR();
  if (!H.skip(NT - 2, wid)) pv_d0(o, vb0, pa0, pa1, pa2, pa3); partialSM<Hook>(pB0, pB1, m_reg, mnB, alB);
  __syncthreads(); AT_RESC(alB);
  finishSM(pB0, pB1, alB, l_reg, pa0, pa1, pa2, pa3); AT_SBAR();
  if (!H.skip(NT - 1, wid)) pv_d0(o, vb0 + SHM_V, pa0, pa1, pa2, pa3);
  asm volatile("s_waitcnt vmcnt(0)" ::: "memory");
  l_out = l_reg;
#undef AT_SLOAD
#undef AT_SWRITE
#undef AT_SWAIT
#undef AT_RESC
}
__device__ __forceinline__ void row_rcp(float l_reg, char* lds, int wid, int r32, int hi, float (&rli)[16]) {
  float* li_l = (float*)(lds + OFF_WS) + wid * 64;
  if (hi == 0) li_l[r32] = l_reg; asm volatile("s_waitcnt lgkmcnt(0)" ::: "memory");
#pragma unroll
  for (int r = 0; r < 16; ++r) rli[r] = __builtin_amdgcn_rcpf(li_l[crow(r, hi)]);
  asm volatile("s_waitcnt lgkmcnt(0)" ::: "memory");
}

struct HookNA { static constexpr float SCALE = 0.08838834764831845f;
  int r0, rs_lo, nw; const float* bias;
  __device__ __forceinline__ long krow(int j) const { return j < nw ? (long)(rs_lo + j) * 64 : (j < nw + 4 ? (long)SEQ + (j - nw) * 64 : (long)SEQ); }
  __device__ __forceinline__ bool skip(int j, int wid) const {
    if (j >= nw) return j >= nw + 4;
    const int rq = r0 + (wid >> 1), kr = rs_lo + j; int rs = rq - 4; rs = rs < 0 ? 0 : (rs > 248 ? 248 : rs);
    return kr < rs || kr > rs + 7; }
  __device__ __forceinline__ void init(f32x16& p0, f32x16& p1, int j, int wid, int r32, int hi) const {
    const float ninf = -__builtin_inff();
    if (j >= nw) { const float v = (j >= nw + 4) ? ninf : 0.f;
#pragma unroll
      for (int r = 0; r < 16; ++r) { p0[r] = v; p1[r] = v; }
      return; }
    const int rq = r0 + (wid >> 1), c = (wid & 1) * 32 + r32, kr = rs_lo + j;
    int rs = rq - 4; rs = rs < 0 ? 0 : (rs > 248 ? 248 : rs); int cs = c - 8; cs = cs < 0 ? 0 : (cs > 48 ? 48 : cs);
    if (kr < rs || kr > rs + 7) {
#pragma unroll
      for (int r = 0; r < 16; ++r) { p0[r] = ninf; p1[r] = ninf; }
      return; }
    const float* brow = bias + (kr - rq + 7) * 32 + (15 - c) + 4 * hi; const int b0 = 4 * hi - cs;
#pragma unroll
    for (int r = 0; r < 16; ++r) { const int cr = (r & 3) + 8 * (r >> 2);
      const float x0 = brow[cr], x1 = brow[32 + cr];
      p0[r] = ((unsigned)(b0 + cr) < 16u) ? x0 : ninf; p1[r] = ((unsigned)(b0 + 32 + cr) < 16u) ? x1 : ninf; }
  } };
__device__ __forceinline__ void na_item(int h, int rb, const bf16_t* qb, const bf16_t* kb, const bf16_t* vb, const float* __restrict__ rpb, bf16_t* outb, char* lds) {
  int tid = threadIdx.x; asm volatile("" : "+v"(tid));
  const int wid = tid >> 6, lane = tid & 63, r32 = lane & 31, hi = lane >> 5; const int r0 = rb * 4; const long t0 = (long)r0 * 64;
  float* btab = (float*)(lds + OFF_STASH);
  __syncthreads();
  for (int e = tid; e < 15 * 32; e += 512) { const int dr = e >> 5, dc = e & 31; btab[e] = dc < 31 ? rpb[(h * 15 + dr) * 31 + dc] * 11.313708498984761f : 0.f; }
  HookNA H; H.r0 = r0; int lo = r0 - 4; lo = lo < 0 ? 0 : (lo > 248 ? 248 : lo); int hr = r0 + 3 - 4; hr = hr < 0 ? 0 : (hr > 248 ? 248 : hr);
  H.rs_lo = lo; H.nw = hr + 7 - lo + 1; H.bias = btab;
  const int NT = (H.nw + 4 + 1) & ~1;
  f32x16 o[4]; float l; float rli[16];
  attn_pass<8, HookNA>(qb + t0 * LDQ + h * 128, kb + h * 128, vb + h * 128, NT, 0, H, lds, o, l);
  row_rcp(l, lds, wid, r32, hi, rli);
#pragma unroll
  for (int r = 0; r < 16; ++r) { bf16_t* op = outb + (t0 + wid * 32 + crow(r, hi)) * 2048 + h * 128 + r32;
#pragma unroll
    for (int d0 = 0; d0 < 4; ++d0) op[d0 * 32] = f2bf(o[d0][r] * rli[r]); }
}
}

namespace da {
using at::bf16x8; using at::s16x4; using at::f32x16; using at::u32x4; using at::crow; using at::cvtpk; using at::tr_read; using at::v_rd_off; using at::v_rd_base;
constexpr int OFF_Q = 0, OFF_KR = 32768, KSLOT = 8192, OFF_VR = 49152, SLOTV = 8192;
#define DA_LAS __attribute__((address_space(3)))
template <int CTRL> __device__ __forceinline__ float dppm(float v) { return __int_as_float(__builtin_amdgcn_update_dpp(0, __float_as_int(v), CTRL, 0xF, 0xF, true)); }
__device__ __forceinline__ float half_sum32(float x) {
  x += dppm<0xB1>(x); x += dppm<0x4E>(x);
  x += dppm<0x141>(x);
  x += dppm<0x140>(x);
  auto r = __builtin_amdgcn_permlane16_swap(__float_as_uint(x), __float_as_uint(x), false, false);
  return __uint_as_float(r[0]) + __uint_as_float(r[1]);
}
template <int OFF> __device__ __forceinline__ bf16x8 lds_rd128(unsigned addr) { bf16x8 r; asm volatile("ds_read_b128 %0, %1 offset:%2" : "=v"(r) : "v"(addr), "i"(OFF) : "memory"); return r; }
#define DA_WAIT() do { asm volatile("s_waitcnt lgkmcnt(0)" ::: "memory"); AT_SBAR(); } while (0)
typedef int i32x8 __attribute__((ext_vector_type(8)));
template <int OFF> __device__ __forceinline__ void rd32(bf16x8& lo, bf16x8& hi_, unsigned a0, unsigned a1) { lo = lds_rd128<OFF>(a0); hi_ = lds_rd128<OFF>(a1); }
__device__ __forceinline__ f32x16 qk1(const bf16x8& klo, const bf16x8& khi, const bf16x8& qlo, const bf16x8& qhi) {
  const u32x4 a = *reinterpret_cast<const u32x4*>(&klo), b = *reinterpret_cast<const u32x4*>(&khi), c = *reinterpret_cast<const u32x4*>(&qlo), d = *reinterpret_cast<const u32x4*>(&qhi);
  const i32x8 A = {(int)a[0], (int)a[1], (int)a[2], (int)a[3], (int)b[0], (int)b[1], (int)b[2], (int)b[3]}, B = {(int)c[0], (int)c[1], (int)c[2], (int)c[3], (int)d[0], (int)d[1], (int)d[2], (int)d[3]};
  return __builtin_amdgcn_mfma_scale_f32_32x32x64_f8f6f4(A, B, f32x16{}, 0, 0, 0, 0x7f7f7f7f, 0, 0x7f7f7f7f);
}
template <bool SHIFT>
__device__ __forceinline__ void sm_fin(f32x16& s, float nb, u32x4& pk) {
#pragma unroll
  for (int r = 0; r < 16; ++r) s[r] = __builtin_amdgcn_exp2f(SHIFT ? s[r] + nb : s[r]);
#pragma unroll
  for (int q = 0; q < 4; ++q) { int w = 0; w = __builtin_amdgcn_cvt_pk_bf8_f32(s[4 * q], s[4 * q + 1], w, false); w = __builtin_amdgcn_cvt_pk_bf8_f32(s[4 * q + 2], s[4 * q + 3], w, true); pk[q] = (unsigned)w; }
}
template <bool SHIFT>
__device__ __forceinline__ void tile_sm(const unsigned (&kc)[4], const unsigned (&qb)[4], float nb1, float nb2, u32x4 (&p1)[2], u32x4 (&p2)[2]) {
  bf16x8 ql, qh, kl, kh; f32x16 s0, s1;
  rd32<0>(ql, qh, qb[0], qb[1]); rd32<0>(kl, kh, kc[0], kc[1]);
  DA_WAIT(); s0 = qk1(kl, kh, ql, qh); AT_SBAR();
  rd32<4096>(kl, kh, kc[0], kc[1]);
  DA_WAIT(); s1 = qk1(kl, kh, ql, qh); AT_SBAR();
  rd32<0>(ql, qh, qb[2], qb[3]); rd32<0>(kl, kh, kc[2], kc[3]); AT_SBAR();
  sm_fin<SHIFT>(s0, nb1, p1[0]);
  DA_WAIT(); s0 = qk1(kl, kh, ql, qh); AT_SBAR();
  rd32<4096>(kl, kh, kc[2], kc[3]); AT_SBAR();
  sm_fin<SHIFT>(s1, nb1, p1[1]);
  DA_WAIT(); s1 = qk1(kl, kh, ql, qh); AT_SBAR();
  sm_fin<SHIFT>(s0, nb2, p2[0]);
  AT_SBAR();
  sm_fin<SHIFT>(s1, nb2, p2[1]);
  AT_SBAR();
}
__device__ __forceinline__ void tile_pv(unsigned v0, unsigned v1, const u32x4 (&p1)[2], const u32x4 (&p2)[2], f32x16 (&o1)[4], f32x16 (&o2)[4], f32x16& L1, f32x16& L2) {
  const i32x8 A1 = {(int)p1[0][0], (int)p1[0][1], (int)p1[0][2], (int)p1[0][3], (int)p1[1][0], (int)p1[1][1], (int)p1[1][2], (int)p1[1][3]};
  const i32x8 A2 = {(int)p2[0][0], (int)p2[0][1], (int)p2[0][2], (int)p2[0][3], (int)p2[1][0], (int)p2[1][1], (int)p2[1][2], (int)p2[1][3]};
  bf16x8 al, ah, bl, bh;
#define DA_PV(D0, L, H) do { const u32x4 x_ = *reinterpret_cast<const u32x4*>(&L), y_ = *reinterpret_cast<const u32x4*>(&H); \
    const i32x8 B_ = {(int)x_[0], (int)x_[1], (int)x_[2], (int)x_[3], (int)y_[0], (int)y_[1], (int)y_[2], (int)y_[3]}; \
    o1[D0] = __builtin_amdgcn_mfma_scale_f32_32x32x64_f8f6f4(A1, B_, o1[D0], 1, 0, 0, 0x7f7f7f7f, 0, 0x7f7f7f7f); \
    o2[D0] = __builtin_amdgcn_mfma_scale_f32_32x32x64_f8f6f4(A2, B_, o2[D0], 1, 0, 0, 0x7f7f7f7f, 0, 0x7f7f7f7f); } while (0)
  rd32<0>(al, ah, v0, v1);
  DA_WAIT(); rd32<2048>(bl, bh, v0, v1); AT_SBAR(); DA_PV(0, al, ah); AT_SBAR();
  DA_WAIT(); rd32<4096>(al, ah, v0, v1); AT_SBAR(); DA_PV(1, bl, bh); AT_SBAR();
  DA_WAIT(); rd32<6144>(bl, bh, v0, v1); AT_SBAR(); DA_PV(2, al, ah); AT_SBAR();
  DA_WAIT(); DA_PV(3, bl, bh);
  { const i32x8 ONES = {0x38383838, 0x38383838, 0x38383838, 0x38383838, 0x38383838, 0x38383838, 0x38383838, 0x38383838};
    L1 = __builtin_amdgcn_mfma_scale_f32_32x32x64_f8f6f4(A1, ONES, L1, 1, 0, 0, 0x7f7f7f7f, 0, 0x7f7f7f7f);
    L2 = __builtin_amdgcn_mfma_scale_f32_32x32x64_f8f6f4(A2, ONES, L2, 1, 0, 0, 0x7f7f7f7f, 0, 0x7f7f7f7f); }
  AT_SBAR();
#undef DA_PV
}
__device__ __forceinline__ void diff_attn_item(int h, int qb, const bf16_t* qa, const bf16_t* ka, const bf16_t* va, const float* __restrict__ subln, float lam, const unsigned* kmax, bf16_t* outa, char* lds) {
  int tid = threadIdx.x; asm volatile("" : "+v"(tid));
  const int wid = __builtin_amdgcn_readfirstlane(tid >> 6), lane = tid & 63, r32 = lane & 31, hi = lane >> 5; const long t0 = (long)qb * 256;
  constexpr int NT = TOT / 64;
  unsigned soffk, soffv;
  { const int row = 8 * wid + (lane >> 3), c = (lane & 7) ^ ((row >> 1) & 7); soffk = (unsigned)(row * 1024 + (c << 4)); }
  { const int R = 16 * wid + (lane >> 2), c = (lane & 3) ^ ((R >> 2) & 3); soffv = (unsigned)(R * TOT + (c << 4)); }
  const char* kg = (const char*)ka + h * 128; const char* vg = (const char*)va + (size_t)h * 128 * TOT;
  const __amdgpu_buffer_rsrc_t rk = __builtin_amdgcn_make_buffer_rsrc((void*)kg, 0, TOT * 1024, 0x00020000), rv = __builtin_amdgcn_make_buffer_rsrc((void*)vg, 0, 128 * TOT, 0x00020000);
#define DA_STAGE(j) do { DA_LAS void* dk_ = (DA_LAS void*)(lds + OFF_KR + ((j) & 1) * KSLOT + wid * 1024); DA_LAS void* dv_ = (DA_LAS void*)(lds + OFF_VR + ((j) % 3) * SLOTV + wid * 1024); \
    __builtin_amdgcn_raw_ptr_buffer_load_lds(rk, dk_, 16, soffk, (j) * (64 * 1024), 0, 0); __builtin_amdgcn_raw_ptr_buffer_load_lds(rv, dv_, 16, soffv, (j) * 64, 0, 0); } while (0)
  __syncthreads();
  DA_STAGE(0);
#pragma unroll
  for (int i = 0; i < 4; ++i) { const int e = tid + i * 512, row = e >> 3, c = e & 7; const bf16x8 v = *reinterpret_cast<const bf16x8*>((const char*)qa + (t0 + row) * 1024 + h * 128 + c * 16);
    *reinterpret_cast<bf16x8*>(lds + OFF_Q + row * 128 + ((c ^ ((row >> 1) & 7)) << 4)) = v; }
  asm volatile("s_waitcnt vmcnt(0) lgkmcnt(0)" ::: "memory"); __builtin_amdgcn_s_barrier(); asm volatile("" ::: "memory");
  float nb1, nb2;
  const unsigned ldsb = (unsigned)(uintptr_t)lds;
  unsigned kb[4], qbs[4];
  { const int qrow = wid * 32 + r32, sw = (r32 >> 1) & 7;
#pragma unroll
    for (int i = 0; i < 2; ++i) { const unsigned c0 = (unsigned)(((4 * i + 2 * hi) ^ sw) << 4); kb[2 * i] = ldsb + OFF_KR + r32 * 128 + c0; kb[2 * i + 1] = kb[2 * i] ^ 16u; qbs[2 * i] = ldsb + OFF_Q + qrow * 128 + c0; qbs[2 * i + 1] = qbs[2 * i] ^ 16u; } }
  { float sq[2];
#pragma unroll
    for (int i = 0; i < 2; ++i) { float s = 0.f;
#pragma unroll
      for (int p = 0; p < 2; ++p) { const u32x4 w = *(const DA_LAS u32x4*)(uintptr_t)(qbs[2 * i + p]);
#pragma unroll
        for (int d = 0; d < 4; ++d) { const auto f0 = __builtin_amdgcn_cvt_pk_f32_fp8((int)w[d], false), f1 = __builtin_amdgcn_cvt_pk_f32_fp8((int)w[d], true); s += f0[0] * f0[0] + f0[1] * f0[1] + f1[0] * f1[0] + f1[1] * f1[1]; } }
      auto rr = __builtin_amdgcn_permlane32_swap(__float_as_uint(s), __float_as_uint(s), false, false); sq[i] = __uint_as_float(rr[0]) + __uint_as_float(rr[1]); }
    const float k1 = __uint_as_float(kmax[(h * 2 + 0) * 2]) + __uint_as_float(kmax[(h * 2 + 0) * 2 + 1]), k2 = __uint_as_float(kmax[(h * 2 + 1) * 2]) + __uint_as_float(kmax[(h * 2 + 1) * 2 + 1]);
    nb1 = -1.1f * sqrtf(sq[0] * k1); nb2 = -1.1f * sqrtf(sq[1] * k2); }
  f32x16 o1[4] = {}, o2[4] = {}, L1 = {}, L2 = {};
  const unsigned vb0 = ldsb + OFF_VR + r32 * 64 + (((2 * hi) ^ ((r32 >> 2) & 3)) << 4), vb1 = vb0 ^ 16u;
  u32x4 pa1[2], pa2[2];
#define DA_LOOP(SHIFT) do { \
    if (wid < 4) { \
      for (int j = 0; j < NT; ++j) { if (j + 1 < NT) DA_STAGE(j + 1); \
        __builtin_amdgcn_s_setprio(1); tile_sm<SHIFT>(kb, qbs, nb1, nb2, pa1, pa2); __builtin_amdgcn_s_setprio(0); tile_pv(vb0 + (j % 3) * SLOTV, vb1 + (j % 3) * SLOTV, pa1, pa2, o1, o2, L1, L2); \
        _Pragma("unroll") for (int d0 = 0; d0 < 4; ++d0) kb[d0] ^= KSLOT;     \
        asm volatile("s_waitcnt vmcnt(0)" ::: "memory"); __builtin_amdgcn_s_barrier(); asm volatile("" ::: "memory"); } \
    } else { \
      for (int j = 0; j < NT; ++j) { if (j + 1 < NT) DA_STAGE(j + 1); \
        if (j > 0) tile_pv(vb0 + ((j - 1) % 3) * SLOTV, vb1 + ((j - 1) % 3) * SLOTV, pa1, pa2, o1, o2, L1, L2); \
        __builtin_amdgcn_s_setprio(1); tile_sm<SHIFT>(kb, qbs, nb1, nb2, pa1, pa2); __builtin_amdgcn_s_setprio(0); \
        _Pragma("unroll") for (int d0 = 0; d0 < 4; ++d0) kb[d0] ^= KSLOT; \
        asm volatile("s_waitcnt vmcnt(0)" ::: "memory"); __builtin_amdgcn_s_barrier(); asm volatile("" ::: "memory"); } \
      tile_pv(vb0 + ((NT - 1) % 3) * SLOTV, vb1 + ((NT - 1) % 3) * SLOTV, pa1, pa2, o1, o2, L1, L2); \
    } } while (0)
  if (__all(nb1 > -100.f && nb2 > -100.f)) DA_LOOP(false); else DA_LOOP(true);
  __builtin_amdgcn_s_setprio(0);
#undef DA_LOOP
#undef DA_STAGE
  int tid2 = threadIdx.x; asm volatile("" : "+v"(tid2));
  const int wid2 = tid2 >> 6, r32b = tid2 & 31, hib = (tid2 >> 5) & 1;
  float g[4];
#pragma unroll
  for (int d0 = 0; d0 < 4; ++d0) g[d0] = subln[d0 * 32 + r32b];
#pragma unroll
  for (int r = 0; r < 16; ++r) { const float a1 = 1.0f / L1[r], a2 = lam / L2[r]; float v[4]; float ss = 0.f;
#pragma unroll
    for (int d0 = 0; d0 < 4; ++d0) { v[d0] = o1[d0][r] * a1 - o2[d0][r] * a2; ss += v[d0] * v[d0]; }
    ss = half_sum32(ss);
    const float rinv = rsqrtf(ss * (1.0f / 128.0f) + 1e-6f) * 0.8f;
    bf16_t* op = outa + (t0 + wid2 * 32 + crow(r, hib)) * 2048 + h * 128 + r32b;
#pragma unroll
    for (int d0 = 0; d0 < 4; ++d0) op[d0 * 32] = f2bf(v[d0] * rinv * g[d0]); }
}
__device__ __forceinline__ void na_item8(int h, int rb, const bf16_t* qb8, const bf16_t* kb8, const bf16_t* vt8b, const float* __restrict__ rpb, bf16_t* outb, char* lds) {
  int tid = threadIdx.x; asm volatile("" : "+v"(tid));
  const int wid = __builtin_amdgcn_readfirstlane(tid >> 6), lane = tid & 63, r32 = lane & 31, hi = lane >> 5; const int r0 = rb * 4; const long t0 = (long)r0 * 64;
  int lo = r0 - 4; lo = lo < 0 ? 0 : (lo > 248 ? 248 : lo); int hr = r0 + 3 - 4; hr = hr < 0 ? 0 : (hr > 248 ? 248 : hr);
  const int nw = hr + 7 - lo + 1, NT = nw + 4;
  constexpr int OFF_BT = OFF_VR + 3 * SLOTV;
  float* btab = (float*)(lds + OFF_BT);
  unsigned soffk, soffv;
  { const int row = 8 * wid + (lane >> 3), c = (lane & 7) ^ ((row >> 1) & 7); soffk = (unsigned)(row * 1024 + (c << 4)); }
  { const int R = 16 * wid + (lane >> 2), c = (lane & 3) ^ ((R >> 2) & 3); soffv = (unsigned)(R * TOT + (c << 4)); }
  const char* kg = (const char*)kb8 + h * 128; const char* vg = (const char*)vt8b + (size_t)h * 128 * TOT;
  const __amdgpu_buffer_rsrc_t rk = __builtin_amdgcn_make_buffer_rsrc((void*)kg, 0, TOT * 1024, 0x00020000), rv = __builtin_amdgcn_make_buffer_rsrc((void*)vg, 0, 128 * TOT, 0x00020000);
#define NA_KROW(j) ((j) < nw ? (lo + (j)) * 64 : SEQ + ((j) - nw) * 64)
#define NA_STAGE(j) do { const int kr_ = NA_KROW(j); DA_LAS void* dk_ = (DA_LAS void*)(lds + OFF_KR + ((j) & 1) * KSLOT + wid * 1024); DA_LAS void* dv_ = (DA_LAS void*)(lds + OFF_VR + ((j) % 3) * SLOTV + wid * 1024); \
    __builtin_amdgcn_raw_ptr_buffer_load_lds(rk, dk_, 16, soffk, kr_ * 1024, 0, 0); __builtin_amdgcn_raw_ptr_buffer_load_lds(rv, dv_, 16, soffv, kr_, 0, 0); } while (0)
  __syncthreads();
  NA_STAGE(0);
  for (int e = tid; e < 16 * 32; e += 512) { const int dr = e >> 5, dc = e & 31; btab[e] = (dr < 15 && dc < 31) ? rpb[(h * 15 + dr) * 31 + dc] * 1.4426950408889634f - 6.0f : 0.f; }
#pragma unroll
  for (int i = 0; i < 4; ++i) { const int e = tid + i * 512, row = e >> 3, c = e & 7; const bf16x8 v = *reinterpret_cast<const bf16x8*>((const char*)qb8 + (t0 + row) * 1024 + h * 128 + c * 16);
    *reinterpret_cast<bf16x8*>(lds + OFF_Q + row * 128 + ((c ^ ((row >> 1) & 7)) << 4)) = v; }
  asm volatile("s_waitcnt vmcnt(0) lgkmcnt(0)" ::: "memory"); __builtin_amdgcn_s_barrier(); asm volatile("" ::: "memory");
  const unsigned ldsb = (unsigned)(uintptr_t)lds;
  unsigned kb[4]; bf16x8 q1l, q1h, q2l, q2h;
  { const int qrow = wid * 32 + r32, sw = (r32 >> 1) & 7; unsigned qa_[4];
#pragma unroll
    for (int i = 0; i < 2; ++i) { const unsigned c0 = (unsigned)(((4 * i + 2 * hi) ^ sw) << 4); kb[2 * i] = ldsb + OFF_KR + r32 * 128 + c0; kb[2 * i + 1] = kb[2 * i] ^ 16u; qa_[2 * i] = ldsb + OFF_Q + qrow * 128 + c0; qa_[2 * i + 1] = qa_[2 * i] ^ 16u; }
    rd32<0>(q1l, q1h, qa_[0], qa_[1]); rd32<0>(q2l, q2h, qa_[2], qa_[3]); DA_WAIT(); }
  f32x16 o[4] = {}, L = {};
  const unsigned vb0 = ldsb + OFF_VR + r32 * 64 + (((2 * hi) ^ ((r32 >> 2) & 3)) << 4), vb1 = vb0 ^ 16u;
  const int rq = r0 + (wid >> 1), cq = (wid & 1) * 32 + r32; int rs = rq - 4; rs = rs < 0 ? 0 : (rs > 248 ? 248 : rs); int cs = cq - 8; cs = cs < 0 ? 0 : (cs > 48 ? 48 : cs);
  unsigned wmask = 0;
#pragma unroll
  for (int k = 0; k < 32; ++k) { const int cr = (k & 3) + 8 * ((k & 15) >> 2) + 32 * (k >> 4); wmask |= ((unsigned)(4 * hi - cs + cr) < 16u) ? (1u << k) : 0u; }
  const DA_LAS float* blane = (const DA_LAS float*)(uintptr_t)(ldsb + OFF_BT) + (15 - cq) + 4 * hi;
  u32x4 pk[2]; bool pvalid = false;
#define NA_SM(j) do { const int kr = lo + (j); const bool win = (j) < nw; pvalid = !(win && (kr < rs || kr > rs + 7));        \
    if (pvalid) { const DA_LAS float* brow = blane + (kr - rq + 7) * 32; unsigned wm_ = wmask; asm volatile("" : "+v"(wm_));        \
      _Pragma("unroll") for (int blk = 0; blk < 2; ++blk) { f32x16 s; bf16x8 kl, kh, ml, mh; \
        if (blk == 0) { rd32<0>(kl, kh, kb[0], kb[1]); rd32<0>(ml, mh, kb[2], kb[3]); } else { rd32<4096>(kl, kh, kb[0], kb[1]); rd32<4096>(ml, mh, kb[2], kb[3]); } \
        if (win) { _Pragma("unroll") for (int r = 0; r < 16; ++r) { const int cr = (r & 3) + 8 * (r >> 2); const int t_ = __builtin_amdgcn_sbfe((int)wm_, 16 * blk + r, 1);        \
            s[r] = __uint_as_float(((unsigned)t_ & __float_as_uint(brow[32 * blk + cr])) | (~(unsigned)t_ & 0xff800000u)); } } \
        else { _Pragma("unroll") for (int r = 0; r < 16; ++r) s[r] = -6.0f; } \
        DA_WAIT(); \
        { const u32x4 a = *reinterpret_cast<const u32x4*>(&kl), b = *reinterpret_cast<const u32x4*>(&kh), c = *reinterpret_cast<const u32x4*>(&q1l), d = *reinterpret_cast<const u32x4*>(&q1h); \
          const i32x8 A = {(int)a[0], (int)a[1], (int)a[2], (int)a[3], (int)b[0], (int)b[1], (int)b[2], (int)b[3]}, B = {(int)c[0], (int)c[1], (int)c[2], (int)c[3], (int)d[0], (int)d[1], (int)d[2], (int)d[3]}; \
          s = __builtin_amdgcn_mfma_scale_f32_32x32x64_f8f6f4(A, B, s, 0, 0, 0, 0x7f7f7f7f, 0, 0x7f7f7f7f); } \
        { const u32x4 a = *reinterpret_cast<const u32x4*>(&ml), b = *reinterpret_cast<const u32x4*>(&mh), c = *reinterpret_cast<const u32x4*>(&q2l), d = *reinterpret_cast<const u32x4*>(&q2h); \
          const i32x8 A = {(int)a[0], (int)a[1], (int)a[2], (int)a[3], (int)b[0], (int)b[1], (int)b[2], (int)b[3]}, B = {(int)c[0], (int)c[1], (int)c[2], (int)c[3], (int)d[0], (int)d[1], (int)d[2], (int)d[3]}; \
          s = __builtin_amdgcn_mfma_scale_f32_32x32x64_f8f6f4(A, B, s, 0, 0, 0, 0x7f7f7f7f, 0, 0x7f7f7f7f); } \
        sm_fin<false>(s, 0.f, pk[blk]); AT_SBAR(); } } } while (0)
#define NA_PVT(j) do { if (pvalid) { const unsigned v0 = vb0 + ((j) % 3) * SLOTV, v1 = vb1 + ((j) % 3) * SLOTV; \
      const i32x8 A1 = {(int)pk[0][0], (int)pk[0][1], (int)pk[0][2], (int)pk[0][3], (int)pk[1][0], (int)pk[1][1], (int)pk[1][2], (int)pk[1][3]}; \
      bf16x8 al, ah, bl, bh; \
      rd32<0>(al, ah, v0, v1); \
      DA_WAIT(); rd32<2048>(bl, bh, v0, v1); AT_SBAR(); NA_PV(0, al, ah); AT_SBAR(); \
      DA_WAIT(); rd32<4096>(al, ah, v0, v1); AT_SBAR(); NA_PV(1, bl, bh); AT_SBAR(); \
      DA_WAIT(); rd32<6144>(bl, bh, v0, v1); AT_SBAR(); NA_PV(2, al, ah); AT_SBAR(); \
      DA_WAIT(); NA_PV(3, bl, bh); \
      { int o_; asm volatile("v_mov_b32 %0, 0x38383838" : "=v"(o_)); const i32x8 ONES = {o_, o_, o_, o_, o_, o_, o_, o_}; \
        L = __builtin_amdgcn_mfma_scale_f32_32x32x64_f8f6f4(A1, ONES, L, 1, 0, 0, 0x7f7f7f7f, 0, 0x7f7f7f7f); } \
      AT_SBAR(); } } while (0)
#define NA_PV(D0, LL, HH) do { const u32x4 x_ = *reinterpret_cast<const u32x4*>(&LL), y_ = *reinterpret_cast<const u32x4*>(&HH); \
      const i32x8 B_ = {(int)x_[0], (int)x_[1], (int)x_[2], (int)x_[3], (int)y_[0], (int)y_[1], (int)y_[2], (int)y_[3]}; \
      o[D0] = __builtin_amdgcn_mfma_scale_f32_32x32x64_f8f6f4(A1, B_, o[D0], 1, 0, 0, 0x7f7f7f7f, 0, 0x7f7f7f7f); } while (0)
  if (wid < 4) {
#pragma nounroll
    for (int j = 0; j < NT; ++j) { if (j + 1 < NT) NA_STAGE(j + 1);
      __builtin_amdgcn_s_setprio(1); NA_SM(j); __builtin_amdgcn_s_setprio(0); NA_PVT(j);
#pragma unroll
      for (int d0 = 0; d0 < 4; ++d0) kb[d0] ^= KSLOT;
      asm volatile("s_waitcnt vmcnt(0)" ::: "memory"); __builtin_amdgcn_s_barrier(); asm volatile("" ::: "memory"); }
  } else {
#pragma nounroll
    for (int j = 0; j < NT; ++j) { if (j + 1 < NT) NA_STAGE(j + 1);
      if (j > 0) NA_PVT(j - 1);
      __builtin_amdgcn_s_setprio(1); NA_SM(j); __builtin_amdgcn_s_setprio(0);
#pragma unroll
      for (int d0 = 0; d0 < 4; ++d0) kb[d0] ^= KSLOT;
      asm volatile("s_waitcnt vmcnt(0)" ::: "memory"); __builtin_amdgcn_s_barrier(); asm volatile("" ::: "memory"); }
    NA_PVT(NT - 1);
  }
#undef NA_SM
#undef NA_PVT
#undef NA_PV
#undef NA_STAGE
#undef NA_KROW
  int tid2 = threadIdx.x; asm volatile("" : "+v"(tid2));
  const int wid2 = tid2 >> 6, r32b = tid2 & 31, hib = (tid2 >> 5) & 1;
#pragma unroll
  for (int r = 0; r < 16; ++r) { const float il = 1.0f / L[r]; bf16_t* op = outb + (t0 + wid2 * 32 + crow(r, hib)) * 2048 + h * 128 + r32b;
#pragma unroll
    for (int d0 = 0; d0 < 4; ++d0) op[d0 * 32] = f2bf(o[d0][r] * il); }
}
}

namespace pe {
typedef short bf16x8 __attribute__((ext_vector_type(8)));
typedef float f32x16 __attribute__((ext_vector_type(16)));
typedef unsigned u32x4 __attribute__((ext_vector_type(4)));
typedef float f32x2 __attribute__((ext_vector_type(2)));
__device__ __forceinline__ float gelu_tanh_fast(float x) { const float u = 0.7978845608028654f * (x + 0.044715f * x * x * x); const float e = __builtin_amdgcn_exp2f(u * 2.8853900817779268f); return x * (1.0f - __builtin_amdgcn_rcpf(e + 1.0f)); }
}

namespace p6 {
typedef float v32f __attribute__((ext_vector_type(32)));
typedef unsigned v6u __attribute__((ext_vector_type(6)));
typedef unsigned u32x4 __attribute__((ext_vector_type(4)));
__device__ __forceinline__ unsigned enc_fp6(float x) {
  const float a = fabsf(x); unsigned c;
  if (a < 2.0f) c = (unsigned)__float2int_rn(a * 8.0f);
  else if (a < 4.0f) c = 16u + (unsigned)__float2int_rn((a - 2.0f) * 4.0f);
  else c = 24u + (unsigned)__float2int_rn((a - 4.0f) * 2.0f);
  c = c > 31u ? 31u : c;
  return c | (x < 0.f ? 32u : 0u);
}
__device__ __forceinline__ unsigned enc_fp4(float x) {
  const float a = fabsf(x); unsigned c;
  if (a < 2.0f) c = (unsigned)__float2int_rn(a * 2.0f);
  else if (a < 4.0f) c = 4u + (unsigned)__float2int_rn(a - 2.0f);
  else c = 6u + (unsigned)__float2int_rn((a - 4.0f) * 0.5f);
  c = c > 7u ? 7u : c;
  return c | (x < 0.f ? 8u : 0u);
}
__device__ __forceinline__ void quant_fin4(const float (&v)[32], unsigned char* dst, float* scale, int lane) {
  float mx = 0.f;
#pragma unroll
  for (int j = 0; j < 32; ++j) mx = fmaxf(mx, fabsf(v[j]));
  for (int o = 32; o >= 1; o >>= 1) mx = fmaxf(mx, __shfl_xor(mx, o));
  mx = fmaxf(mx, 1e-30f); const float inv = 6.0f / mx;
  unsigned w[4] = {0u, 0u, 0u, 0u};
#pragma unroll
  for (int d = 0; d < 4; ++d) {
    w[d] = __builtin_amdgcn_cvt_scalef32_pk_fp4_f32(w[d], v[8 * d] * inv, v[8 * d + 1] * inv, 1.0f, 0); w[d] = __builtin_amdgcn_cvt_scalef32_pk_fp4_f32(w[d], v[8 * d + 2] * inv, v[8 * d + 3] * inv, 1.0f, 1);
    w[d] = __builtin_amdgcn_cvt_scalef32_pk_fp4_f32(w[d], v[8 * d + 4] * inv, v[8 * d + 5] * inv, 1.0f, 2); w[d] = __builtin_amdgcn_cvt_scalef32_pk_fp4_f32(w[d], v[8 * d + 6] * inv, v[8 * d + 7] * inv, 1.0f, 3); }
  *(u32x4*)(dst + lane * 16) = (u32x4){w[0], w[1], w[2], w[3]};
  if (lane == 0) *scale = mx * (1.0f / 6.0f);
}
__device__ __forceinline__ void quant_fin4b(const float (&v)[32], unsigned char* dst, int lane) {
  float mx = 0.f;
#pragma unroll
  for (int j = 0; j < 32; ++j) mx = fmaxf(mx, fabsf(v[j]));
  const int s8 = __builtin_amdgcn_cvt_pk_fp8_f32(mx * (512.0f / 6.0f), 0.f, 0, false) & 0xff;
  const float dec = __builtin_amdgcn_cvt_pk_f32_fp8(s8, false)[0] * (1.0f / 512.0f);
  const float inv = dec > 0.f ? 1.0f / dec : 0.f;
  unsigned w[4] = {0u, 0u, 0u, 0u};
#pragma unroll
  for (int d = 0; d < 4; ++d) {
    w[d] = __builtin_amdgcn_cvt_scalef32_pk_fp4_f32(w[d], v[8 * d] * inv, v[8 * d + 1] * inv, 1.0f, 0); w[d] = __builtin_amdgcn_cvt_scalef32_pk_fp4_f32(w[d], v[8 * d + 2] * inv, v[8 * d + 3] * inv, 1.0f, 1);
    w[d] = __builtin_amdgcn_cvt_scalef32_pk_fp4_f32(w[d], v[8 * d + 4] * inv, v[8 * d + 5] * inv, 1.0f, 2); w[d] = __builtin_amdgcn_cvt_scalef32_pk_fp4_f32(w[d], v[8 * d + 6] * inv, v[8 * d + 7] * inv, 1.0f, 3); }
  *(u32x4*)(dst + lane * 16) = (u32x4){w[0], w[1], w[2], w[3]};
  dst[1024 + lane] = (unsigned char)s8;
}
__device__ __forceinline__ void quant_load_nat(const float* __restrict__ src, float (&v)[32], int lane) {
#pragma unroll
  for (int q = 0; q < 8; ++q) { const float4 t = *(const float4*)(src + lane * 32 + q * 4); v[q * 4] = t.x; v[q * 4 + 1] = t.y; v[q * 4 + 2] = t.z; v[q * 4 + 3] = t.w; }
}
__device__ __forceinline__ void quant_load(const float* __restrict__ src, float (&v)[32], int lane) {
#pragma unroll
  for (int c = 0; c < 2; ++c)
#pragma unroll
    for (int q = 0; q < 4; ++q) { const float4 t = *(const float4*)(src + c * 1024 + lane * 16 + q * 4); v[c * 16 + q * 4] = t.x; v[c * 16 + q * 4 + 1] = t.y; v[c * 16 + q * 4 + 2] = t.z; v[c * 16 + q * 4 + 3] = t.w; }
}
__device__ __forceinline__ void quant_fin(const float (&v)[32], unsigned char* dst, float* scale, int lane) {
  float mx = 0.f;
#pragma unroll
  for (int j = 0; j < 32; ++j) mx = fmaxf(mx, fabsf(v[j]));
  for (int o = 32; o >= 1; o >>= 1) mx = fmaxf(mx, __shfl_xor(mx, o));
  mx = fmaxf(mx, 1e-30f); const float inv = 7.5f / mx;
  unsigned w[6] = {0u, 0u, 0u, 0u, 0u, 0u};
#pragma unroll
  for (int j = 0; j < 32; ++j) { const unsigned code = enc_fp6(v[j] * inv); const int bit = 6 * j, d = bit >> 5, s = bit & 31;
    w[d] |= code << s; if (s > 26) w[d + 1] |= code >> (32 - s); }
  *(u32x4*)(dst + lane * 16) = (u32x4){w[0], w[1], w[2], w[3]}; *(uint2*)(dst + 1024 + lane * 8) = make_uint2(w[4], w[5]);
  if (lane == 0) *scale = mx * (1.0f / 7.5f);
}
template <int CTRL> __device__ __forceinline__ float dpp_mov(float v) { return __int_as_float(__builtin_amdgcn_update_dpp(0, __float_as_int(v), CTRL, 0xF, 0xF, true)); }
__device__ __forceinline__ float reduce16(const float (&p)[16], int lane) {
  float q[8], w[4], y[2];
#pragma unroll
  for (int i = 0; i < 8; ++i) { auto r = __builtin_amdgcn_permlane32_swap(__float_as_uint(p[2 * i]), __float_as_uint(p[2 * i + 1]), false, false); q[i] = __uint_as_float(r[0]) + __uint_as_float(r[1]); }
#pragma unroll
  for (int i = 0; i < 4; ++i) { auto r = __builtin_amdgcn_permlane16_swap(__float_as_uint(q[2 * i]), __float_as_uint(q[2 * i + 1]), false, false); w[i] = __uint_as_float(r[0]) + __uint_as_float(r[1]); }
  const bool b3 = (lane & 8) != 0, b2 = (lane & 4) != 0;
#pragma unroll
  for (int i = 0; i < 2; ++i) { const float t = b3 ? w[2 * i + 1] : w[2 * i], u = b3 ? w[2 * i] : w[2 * i + 1]; y[i] = t + dpp_mov<0x128>(u); }
  const float t = b2 ? y[1] : y[0], u = b2 ? y[0] : y[1];
  float z = t + dpp_mov<0x141>(u);
  z += dpp_mov<0xB1>(z); z += dpp_mov<0x4E>(z);
  return z;
}
typedef float f32x2 __attribute__((ext_vector_type(2)));
typedef int i32x8 __attribute__((ext_vector_type(8)));
typedef float f32x4v __attribute__((ext_vector_type(4)));
__device__ __forceinline__ float wsum64(float x) { x = da::half_sum32(x); auto r = __builtin_amdgcn_permlane32_swap(__float_as_uint(x), __float_as_uint(x), false, false); return __uint_as_float(r[0]) + __uint_as_float(r[1]); }
__device__ __forceinline__ void expert_tokens(int t0, int tstride, int lane, char* ldsw, float* xio, const bf16_t* __restrict__ h2g, const float* __restrict__ mod, const int* __restrict__ pidx, const float* __restrict__ pgate,
                                              const unsigned char* __restrict__ U6, const float* __restrict__ uscale, const unsigned char* __restrict__ V6, const float* __restrict__ fg_) {
  if (t0 >= SEQ) return;
  const int kg = lane >> 4;
  u32x4 A[8], B[8]; unsigned sA[8], sB[8];
  int id0 = pidx[(size_t)t0 * 128 + lane], id1 = pidx[(size_t)t0 * 128 + 64 + lane];
#define P6_ID(k) ({ const int k_ = (k); const int a_ = __builtin_amdgcn_readlane(id0, k_ & 63), b_ = __builtin_amdgcn_readlane(id1, k_ & 63); (k_ & 64) ? b_ : a_; })
#define P6_LOADU(BUF, IDROW, HALF) do { const unsigned char* rp_ = U6 + (size_t)(IDROW) * 1024 + kg * 16 + (HALF) * 512; _Pragma("unroll") for (int r = 0; r < 8; ++r) BUF[r] = *(const u32x4*)(rp_ + r * 64); } while (0)
#define P6_LOADV(BUF, SB, KBASE) do { _Pragma("unroll") for (int r = 0; r < 8; ++r) { const int id_ = P6_ID((KBASE) + r); const unsigned char* vp_ = V6 + (size_t)id_ * 1088; BUF[r] = *(const u32x4*)(vp_ + lane * 16); SB[r] = vp_[1024 + lane]; } } while (0)
#define P6_COMPU(BUF, HALF) do { _Pragma("unroll") for (int r = 0; r < 8; ++r) { const char* bp_ = ldsw + ((HALF) * 8 + r) * 128 + kg * 16; const u32x4 b0_ = *(const u32x4*)bp_, b1_ = *(const u32x4*)(bp_ + 64);        \
      const i32x8 a8_ = {(int)BUF[r].x, (int)BUF[r].y, (int)BUF[r].z, (int)BUF[r].w, 0, 0, 0, 0}, b8_ = {(int)b0_.x, (int)b0_.y, (int)b0_.z, (int)b0_.w, (int)b1_.x, (int)b1_.y, (int)b1_.z, (int)b1_.w}; \
      acc = __builtin_amdgcn_mfma_scale_f32_16x16x128_f8f6f4(a8_, b8_, acc, 4, 0, 0, 0x7f7f7f7f, 0, 0x7f7f7f7f); } } while (0)
#define P6_COMPV(BUF, SB, HALF) do { _Pragma("unroll") for (int r = 0; r < 8; ++r) { const int ee = (HALF) * 8 + r; const float ae = __int_as_float(__builtin_amdgcn_readlane(__float_as_int(a[ee & 3]), (ee >> 2) * 16)); \
      asm volatile("" : "+v"(BUF[r].x) : "v"(outp[15]));        \
      const float cs = ae * __builtin_amdgcn_cvt_pk_f32_fp8((int)SB[r], false)[0]; const f32x2 cc = {cs, cs}; \
      _Pragma("unroll") for (int d = 0; d < 4; ++d) { const unsigned wv_ = BUF[r][d]; \
        const f32x2 f0 = __builtin_amdgcn_cvt_scalef32_pk_f32_fp4(wv_, 1.0f, 0), f1 = __builtin_amdgcn_cvt_scalef32_pk_f32_fp4(wv_, 1.0f, 1), f2 = __builtin_amdgcn_cvt_scalef32_pk_f32_fp4(wv_, 1.0f, 2), f3 = __builtin_amdgcn_cvt_scalef32_pk_f32_fp4(wv_, 1.0f, 3); \
        outp[4 * d] = __builtin_elementwise_fma(f0, cc, outp[4 * d]); outp[4 * d + 1] = __builtin_elementwise_fma(f1, cc, outp[4 * d + 1]); outp[4 * d + 2] = __builtin_elementwise_fma(f2, cc, outp[4 * d + 2]); outp[4 * d + 3] = __builtin_elementwise_fma(f3, cc, outp[4 * d + 3]); } } } while (0)
  int idrow = __shfl(id0, lane & 15);
  P6_LOADU(A, idrow, 0);
  for (int t = t0; t < SEQ; t += tstride) {
    int lt = lane; asm volatile("" : "+v"(lt));
    int z; asm volatile("s_mov_b32 %0, 0" : "=s"(z));
    const float* fg = fg_ + z; const float* gt2 = mod + 5 * DM + z;
    const int tn = t + tstride < SEQ ? t + tstride : t;
    const int nid0 = pidx[(size_t)tn * 128 + lane], nid1 = pidx[(size_t)tn * 128 + 64 + lane];
#pragma unroll
    for (int c = 0; c < 2; ++c) { const u32x4 ha = *(const u32x4*)(h2g + (size_t)t * DM + c * 1024 + lt * 16), hb = *(const u32x4*)(h2g + (size_t)t * DM + c * 1024 + lt * 16 + 8); const unsigned hw[8] = {ha.x, ha.y, ha.z, ha.w, hb.x, hb.y, hb.z, hb.w}; unsigned wq[4];
#pragma unroll
      for (int q = 0; q < 4; ++q) { const float f0 = __uint_as_float(hw[2 * q] << 16) * 8.0f, f1 = __uint_as_float(hw[2 * q] & 0xffff0000u) * 8.0f, f2 = __uint_as_float(hw[2 * q + 1] << 16) * 8.0f, f3 = __uint_as_float(hw[2 * q + 1] & 0xffff0000u) * 8.0f;
        int pk = 0; pk = __builtin_amdgcn_cvt_pk_fp8_f32(f0, f1, pk, false); pk = __builtin_amdgcn_cvt_pk_fp8_f32(f2, f3, pk, true); wq[q] = (unsigned)pk; }
      *(u32x4*)(ldsw + c * 1024 + lt * 16) = (u32x4){wq[0], wq[1], wq[2], wq[3]}; }
    f32x2 outp[16];
#pragma unroll
    for (int j = 0; j < 16; ++j) outp[j] = f32x2{0.f, 0.f};
    const int* ip = pidx + (size_t)t * 128; const float* gp = pgate + (size_t)t * 128;
    float4 gnx = *(const float4*)(gp + 4 * kg); float4 usn; { const int4 i4 = *(const int4*)(ip + 4 * kg); usn.x = uscale[i4.x]; usn.y = uscale[i4.y]; usn.z = uscale[i4.z]; usn.w = uscale[i4.w]; }
#pragma nounroll
    for (int h = 0; h < 8; ++h) {
      f32x4v acc = {0.f, 0.f, 0.f, 0.f};
      P6_LOADU(B, idrow, 1);
      P6_COMPU(A, 0);
      P6_LOADV(A, sA, h * 16);
      P6_COMPU(B, 1);
      float a[4];
      a[0] = gnx.x * pe::gelu_tanh_fast(acc[0] * usn.x * 0.125f) * (1.0f / 512.0f); a[1] = gnx.y * pe::gelu_tanh_fast(acc[1] * usn.y * 0.125f) * (1.0f / 512.0f);
      a[2] = gnx.z * pe::gelu_tanh_fast(acc[2] * usn.z * 0.125f) * (1.0f / 512.0f); a[3] = gnx.w * pe::gelu_tanh_fast(acc[3] * usn.w * 0.125f) * (1.0f / 512.0f);
      { const int hn = h < 7 ? h + 1 : 7; gnx = *(const float4*)(gp + hn * 16 + 4 * kg); const int4 i4 = *(const int4*)(ip + hn * 16 + 4 * kg); usn.x = uscale[i4.x]; usn.y = uscale[i4.y]; usn.z = uscale[i4.z]; usn.w = uscale[i4.w]; }
      P6_LOADV(B, sB, h * 16 + 8);
      P6_COMPV(A, sA, 0);
      { const int srcv = h < 7 ? (((h + 1) & 4) ? id1 : id0) : nid0; idrow = __shfl(srcv, (h < 7 ? ((h + 1) & 3) * 16 : 0) + (lane & 15)); }
      P6_LOADU(A, idrow, 0);
      P6_COMPV(B, sB, 1);
    }
    id0 = nid0; id1 = nid1;
    float xn[32]; float s2 = 0.f;
#pragma unroll
    for (int c = 0; c < 2; ++c)
#pragma unroll
      for (int q = 0; q < 4; ++q) { const float4 v = *(const float4*)(xio + (size_t)t * DM + c * 1024 + lt * 16 + q * 4); xn[c * 16 + q * 4] = v.x; xn[c * 16 + q * 4 + 1] = v.y; xn[c * 16 + q * 4 + 2] = v.z; xn[c * 16 + q * 4 + 3] = v.w; }
#pragma unroll
    for (int c = 0; c < 2; ++c)
#pragma unroll
      for (int j = 0; j < 16; ++j) { const int col = c * 1024 + lt * 16 + j; const float o_ = (j & 1) ? outp[c * 8 + (j >> 1)].y : outp[c * 8 + (j >> 1)].x; const float y = xn[c * 16 + j] + gt2[col] * o_; xn[c * 16 + j] = y; s2 += y * y; }
    s2 = wsum64(s2); const float r2 = rsqrtf(s2 * (1.0f / DM) + 1e-6f);
#pragma unroll
    for (int c = 0; c < 2; ++c)
#pragma unroll
      for (int q = 0; q < 4; ++q) { const int col = c * 1024 + lt * 16 + q * 4; float4 o; o.x = xn[c * 16 + q * 4] * r2 * fg[col]; o.y = xn[c * 16 + q * 4 + 1] * r2 * fg[col + 1]; o.z = xn[c * 16 + q * 4 + 2] * r2 * fg[col + 2]; o.w = xn[c * 16 + q * 4 + 3] * r2 * fg[col + 3];
        *(float4*)(xio + (size_t)t * DM + col) = o; }
  }
#undef P6_ID
#undef P6_LOADU
#undef P6_LOADV
#undef P6_COMPU
#undef P6_COMPV
}
__device__ __forceinline__ void expert_u_slice(int s, int w0, int wstride, int lane, char* ldsw, const unsigned char* __restrict__ h2f8, const int* __restrict__ pidx, const float* __restrict__ pgate,
                                               const unsigned char* __restrict__ U6, const float* __restrict__ uscale, float* __restrict__ act) {
  if (w0 >= SEQ) return;
  const int n_ = lane & 15, kgb = lane >> 4;
  const int hoff = 32 * n_ + 512 * (kgb >> 1) + 16 * (kgb & 1);
  const bool dg = (kgb == (n_ >> 2)); const int dr = n_ & 3;
  const float mk0 = (dg && dr == 0) ? 1.f : 0.f, mk1 = (dg && dr == 1) ? 1.f : 0.f, mk2 = (dg && dr == 2) ? 1.f : 0.f, mk3 = (dg && dr == 3) ? 1.f : 0.f;
  const int eL = ((lane >> 2) & 1) * 8 + ((lane >> 3) & 1) * 4 + ((lane >> 4) & 1) * 2 + (lane >> 5);
  const unsigned dummy = (255u << 16) | (unsigned)(s * 2048);
#define P6_FILT(CID0, CID1, LST, NOUT) do { const bool in0_ = ((CID0) >> 11) == s, in1_ = ((CID1) >> 11) == s; const unsigned long long m0_ = __ballot(in0_), m1_ = __ballot(in1_); \
    const int n0_ = __popcll(m0_); NOUT = n0_ + __popcll(m1_); (LST)[lane] = dummy; (LST)[64 + lane] = dummy; \
    const int r0_ = __builtin_amdgcn_mbcnt_hi((unsigned)(m0_ >> 32), __builtin_amdgcn_mbcnt_lo((unsigned)m0_, 0)), r1_ = n0_ + __builtin_amdgcn_mbcnt_hi((unsigned)(m1_ >> 32), __builtin_amdgcn_mbcnt_lo((unsigned)m1_, 0)); \
    if (in0_) (LST)[r0_] = ((unsigned)lane << 16) | (unsigned)(CID0); if (in1_) (LST)[r1_] = ((unsigned)(64 + lane) << 16) | (unsigned)(CID1); } while (0)
#define P6_LOADB(BUF, LST, BI) do { const u32x4 ea_ = *(const DA_LAS u32x4*)((LST) + 8 * (BI)), eb_ = *(const DA_LAS u32x4*)((LST) + 8 * (BI) + 4); const unsigned er_[8] = {ea_.x, ea_.y, ea_.z, ea_.w, eb_.x, eb_.y, eb_.z, eb_.w}; \
    _Pragma("unroll") for (int j = 0; j < 8; ++j) { const unsigned id_ = (unsigned)__builtin_amdgcn_readfirstlane((int)er_[j]) & 0xffffu; BUF[j] = *(const u32x4*)(U6 + (size_t)id_ * 1024 + lane * 16); } } while (0)
  const int ntok = (SEQ - w0 + wstride - 1) / wstride;
  DA_LAS unsigned* listC = (DA_LAS unsigned*)(uintptr_t)(unsigned)(uintptr_t)ldsw; DA_LAS unsigned* listN = listC + 128;
  int t = w0, nC, nN;
  { const int i0 = pidx[(size_t)t * 128 + lane], i1 = pidx[(size_t)t * 128 + 64 + lane]; P6_FILT(i0, i1, listC, nC); }
  u32x4 hc0 = *(const u32x4*)(h2f8 + (size_t)t * DM + hoff), hc1 = *(const u32x4*)(h2f8 + (size_t)t * DM + hoff + 1024);
  int tn = ntok > 1 ? t + wstride : t;
  int id0 = pidx[(size_t)tn * 128 + lane], id1 = pidx[(size_t)tn * 128 + 64 + lane];
  u32x4 h0 = *(const u32x4*)(h2f8 + (size_t)tn * DM + hoff), h1 = *(const u32x4*)(h2f8 + (size_t)tn * DM + hoff + 1024);
  u32x4 A[8], B[8];
  P6_LOADB(A, listC, 0);
  for (int it = 0; it < ntok; ++it) {
    P6_FILT(id0, id1, listN, nN);
    const u32x4 hn0 = h0, hn1 = h1;
    const int tnn = it + 2 < ntok ? tn + wstride : tn;
    id0 = pidx[(size_t)tnn * 128 + lane]; id1 = pidx[(size_t)tnn * 128 + 64 + lane];
    h0 = *(const u32x4*)(h2f8 + (size_t)tnn * DM + hoff); h1 = *(const u32x4*)(h2f8 + (size_t)tnn * DM + hoff + 1024);
    const i32x8 b8 = {(int)hc0.x, (int)hc0.y, (int)hc0.z, (int)hc0.w, (int)hc1.x, (int)hc1.y, (int)hc1.z, (int)hc1.w};
    const int NB = (nC + 7) >> 3;
    const float* gp = pgate + (size_t)t * 128;
    if (NB == 0) P6_LOADB(A, listN, 0);
#pragma nounroll
    for (int b = 0; b < NB; ++b) {
      const unsigned ej = listC[8 * b + (eL & 7)];
      const float gt = gp[(ej >> 16) & 127u], us = uscale[ej & 0xffffu];
      asm volatile("" ::: "memory");
      if (b + 1 < NB) P6_LOADB(B, listC, b + 1); else P6_LOADB(B, listN, 0);
      asm volatile("" ::: "memory");
      float part[16];
#pragma unroll
      for (int j = 0; j < 8; ++j) { const i32x8 a8 = {(int)A[j].x, (int)A[j].y, (int)A[j].z, (int)A[j].w, 0, 0, 0, 0};
        const f32x4v d = __builtin_amdgcn_mfma_scale_f32_16x16x128_f8f6f4(a8, b8, f32x4v{0.f, 0.f, 0.f, 0.f}, 4, 0, 0, 0x7f7f7f7f, 0, 0x7f7f7f7f);
        part[j] = d[0] * mk0 + d[1] * mk1 + d[2] * mk2 + d[3] * mk3; part[8 + j] = 0.f; }
      const float tot = reduce16(part, lane);
      const unsigned kk = ej >> 16;
      if (eL < 8 && (lane & 3) == 0 && kk < 128u) act[(size_t)t * 128 + kk] = gt * pe::gelu_tanh_fast(tot * us * 0.125f) * (1.0f / 512.0f);
#pragma unroll
      for (int j = 0; j < 8; ++j) A[j] = B[j];
    }
    { DA_LAS unsigned* x_ = listC; listC = listN; listN = x_; } nC = nN; hc0 = hn0; hc1 = hn1; t = tn; tn = tnn;
  }
#undef P6_FILT
#undef P6_LOADB
}
__device__ __forceinline__ void expert_v_tokens(int t0, int tstride, int lane, float* xio, const float* __restrict__ mod, const int* __restrict__ pidx, const float* __restrict__ act,
                                                const unsigned char* __restrict__ V6, const float* __restrict__ fg_) {
  if (t0 >= SEQ) return;
  u32x4 A[8], B[8]; unsigned sA[8], sB[8];
  int id0 = pidx[(size_t)t0 * 128 + lane], id1 = pidx[(size_t)t0 * 128 + 64 + lane];
#define P6_ID(k) ({ const int k_ = (k); const int a_ = __builtin_amdgcn_readlane(id0, k_ & 63), b_ = __builtin_amdgcn_readlane(id1, k_ & 63); (k_ & 64) ? b_ : a_; })
#define P6_AC(k) ({ const int k_ = (k); const int a_ = __builtin_amdgcn_readlane(__float_as_int(ac0), k_ & 63), b_ = __builtin_amdgcn_readlane(__float_as_int(ac1), k_ & 63); __int_as_float((k_ & 64) ? b_ : a_); })
#define P6_LOADV(BUF, SB, IDEXPR) do { _Pragma("unroll") for (int r = 0; r < 8; ++r) { const int id_ = (IDEXPR); const unsigned char* vp_ = V6 + (size_t)id_ * 1088; BUF[r] = *(const u32x4*)(vp_ + lane * 16); SB[r] = vp_[1024 + lane]; } } while (0)
#define P6_COMPV(BUF, SB, KBASE) do { _Pragma("unroll") for (int r = 0; r < 8; ++r) { const float ae = P6_AC((KBASE) + r); \
      asm volatile("" : "+v"(BUF[r].x) : "v"(outp[15]));        \
      const float cs = ae * __builtin_amdgcn_cvt_pk_f32_fp8((int)SB[r], false)[0]; const f32x2 cc = {cs, cs}; \
      _Pragma("unroll") for (int d = 0; d < 4; ++d) { const unsigned wv_ = BUF[r][d]; \
        const f32x2 f0 = __builtin_amdgcn_cvt_scalef32_pk_f32_fp4(wv_, 1.0f, 0), f1 = __builtin_amdgcn_cvt_scalef32_pk_f32_fp4(wv_, 1.0f, 1), f2 = __builtin_amdgcn_cvt_scalef32_pk_f32_fp4(wv_, 1.0f, 2), f3 = __builtin_amdgcn_cvt_scalef32_pk_f32_fp4(wv_, 1.0f, 3); \
        outp[4 * d] = __builtin_elementwise_fma(f0, cc, outp[4 * d]); outp[4 * d + 1] = __builtin_elementwise_fma(f1, cc, outp[4 * d + 1]); outp[4 * d + 2] = __builtin_elementwise_fma(f2, cc, outp[4 * d + 2]); outp[4 * d + 3] = __builtin_elementwise_fma(f3, cc, outp[4 * d + 3]); } } } while (0)
  float gtv[32], fgv[32];
#pragma unroll
  for (int c = 0; c < 2; ++c)
#pragma unroll
    for (int j = 0; j < 16; ++j) { gtv[c * 16 + j] = mod[5 * DM + c * 1024 + lane * 16 + j]; fgv[c * 16 + j] = fg_[c * 1024 + lane * 16 + j]; }
  float nac0 = act[(size_t)t0 * 128 + lane], nac1 = act[(size_t)t0 * 128 + 64 + lane];
  P6_LOADV(A, sA, P6_ID(r));
  for (int t = t0; t < SEQ; t += tstride) {
    int lt = lane; asm volatile("" : "+v"(lt));
    const int tn = t + tstride < SEQ ? t + tstride : t;
    const int nid0 = pidx[(size_t)tn * 128 + lane], nid1 = pidx[(size_t)tn * 128 + 64 + lane];
    const float ac0 = nac0, ac1 = nac1; nac0 = act[(size_t)tn * 128 + lane]; nac1 = act[(size_t)tn * 128 + 64 + lane];
    f32x2 outp[16]; float4 xv[8];
#pragma unroll
    for (int j = 0; j < 16; ++j) outp[j] = f32x2{0.f, 0.f};
#pragma nounroll
    for (int h = 0; h < 8; ++h) {
      P6_LOADV(B, sB, P6_ID(h * 16 + 8 + r));
      P6_COMPV(A, sA, h * 16);
      if (h < 7) P6_LOADV(A, sA, P6_ID(h * 16 + 16 + r));
      else {
#pragma unroll
        for (int c = 0; c < 2; ++c)
#pragma unroll
          for (int q = 0; q < 4; ++q) xv[c * 4 + q] = *(const float4*)(xio + (size_t)t * DM + c * 1024 + lt * 16 + q * 4);
        asm volatile("" ::: "memory");
        P6_LOADV(A, sA, __builtin_amdgcn_readlane(nid0, r)); }
      P6_COMPV(B, sB, h * 16 + 8);
    }
    id0 = nid0; id1 = nid1;
    float xn[32]; float s2 = 0.f;
#pragma unroll
    for (int c = 0; c < 2; ++c)
#pragma unroll
      for (int q = 0; q < 4; ++q) { const float4 v = xv[c * 4 + q]; xn[c * 16 + q * 4] = v.x; xn[c * 16 + q * 4 + 1] = v.y; xn[c * 16 + q * 4 + 2] = v.z; xn[c * 16 + q * 4 + 3] = v.w; }
#pragma unroll
    for (int c = 0; c < 2; ++c)
#pragma unroll
      for (int j = 0; j < 16; ++j) { const int col = c * 1024 + lt * 16 + j; const float o_ = (j & 1) ? outp[c * 8 + (j >> 1)].y : outp[c * 8 + (j >> 1)].x; const float y = xn[c * 16 + j] + gtv[c * 16 + j] * o_; xn[c * 16 + j] = y; s2 += y * y; }
    s2 = wsum64(s2); const float r2 = rsqrtf(s2 * (1.0f / DM) + 1e-6f);
#pragma unroll
    for (int c = 0; c < 2; ++c)
#pragma unroll
      for (int q = 0; q < 4; ++q) { const int col = c * 1024 + lt * 16 + q * 4; float4 o; o.x = xn[c * 16 + q * 4] * r2 * fgv[c * 16 + q * 4]; o.y = xn[c * 16 + q * 4 + 1] * r2 * fgv[c * 16 + q * 4 + 1]; o.z = xn[c * 16 + q * 4 + 2] * r2 * fgv[c * 16 + q * 4 + 2]; o.w = xn[c * 16 + q * 4 + 3] * r2 * fgv[c * 16 + q * 4 + 3];
        *(float4*)(xio + (size_t)t * DM + col) = o; }
  }
#undef P6_ID
#undef P6_AC
#undef P6_LOADV
#undef P6_COMPV
}
}

namespace tk {
typedef short bf16x8 __attribute__((ext_vector_type(8)));
typedef float f32x16 __attribute__((ext_vector_type(16)));
typedef unsigned u32x4 __attribute__((ext_vector_type(4)));
typedef float f32x4 __attribute__((ext_vector_type(4)));
constexpr int OFF_SCR = 65536;
__device__ __forceinline__ float vmax(float a, float b) { float r; asm("v_max_f32 %0, %1, %2" : "=v"(r) : "v"(a), "v"(b)); return r; }
__device__ __forceinline__ float vmin(float a, float b) { float r; asm("v_min_f32 %0, %1, %2" : "=v"(r) : "v"(a), "v"(b)); return r; }
#define TK_CE(A, i, j) { const float hi_ = vmax(A[i], A[j]); A[j] = vmin(A[i], A[j]); A[i] = hi_; }
__device__ __forceinline__ void sort16(f32x16& a) { TK_CE(a, 0,1) TK_CE(a, 2,3) TK_CE(a, 0,2) TK_CE(a, 1,3) TK_CE(a, 1,2) TK_CE(a, 4,5) TK_CE(a, 6,7) TK_CE(a, 4,6) TK_CE(a, 5,7) TK_CE(a, 5,6) TK_CE(a, 0,4) TK_CE(a, 2,6) TK_CE(a, 2,4) TK_CE(a, 1,5) TK_CE(a, 3,7) TK_CE(a, 3,5) TK_CE(a, 1,2) TK_CE(a, 3,4) TK_CE(a, 5,6) TK_CE(a, 8,9) TK_CE(a, 10,11) TK_CE(a, 8,10) TK_CE(a, 9,11) TK_CE(a, 9,10) TK_CE(a, 12,13) TK_CE(a, 14,15) TK_CE(a, 12,14) TK_CE(a, 13,15) TK_CE(a, 13,14) TK_CE(a, 8,12) TK_CE(a, 10,14) TK_CE(a, 10,12) TK_CE(a, 9,13) TK_CE(a, 11,15) TK_CE(a, 11,13) TK_CE(a, 9,10) TK_CE(a, 11,12) TK_CE(a, 13,14) TK_CE(a, 0,8) TK_CE(a, 4,12) TK_CE(a, 4,8) TK_CE(a, 2,10) TK_CE(a, 6,14) TK_CE(a, 6,10) TK_CE(a, 2,4) TK_CE(a, 6,8) TK_CE(a, 10,12) TK_CE(a, 1,9) TK_CE(a, 5,13) TK_CE(a, 5,9) TK_CE(a, 3,11) TK_CE(a, 7,15) TK_CE(a, 7,11) TK_CE(a, 3,5) TK_CE(a, 7,9) TK_CE(a, 11,13) TK_CE(a, 1,2) TK_CE(a, 3,4) TK_CE(a, 5,6) TK_CE(a, 7,8) TK_CE(a, 9,10) TK_CE(a, 11,12) TK_CE(a, 13,14) }
__device__ __forceinline__ void bitonic16(f32x16& a) { TK_CE(a, 0,8) TK_CE(a, 1,9) TK_CE(a, 2,10) TK_CE(a, 3,11) TK_CE(a, 4,12) TK_CE(a, 5,13) TK_CE(a, 6,14) TK_CE(a, 7,15) TK_CE(a, 0,4) TK_CE(a, 1,5) TK_CE(a, 2,6) TK_CE(a, 3,7) TK_CE(a, 8,12) TK_CE(a, 9,13) TK_CE(a, 10,14) TK_CE(a, 11,15) TK_CE(a, 0,2) TK_CE(a, 1,3) TK_CE(a, 4,6) TK_CE(a, 5,7) TK_CE(a, 8,10) TK_CE(a, 9,11) TK_CE(a, 12,14) TK_CE(a, 13,15) TK_CE(a, 0,1) TK_CE(a, 2,3) TK_CE(a, 4,5) TK_CE(a, 6,7) TK_CE(a, 8,9) TK_CE(a, 10,11) TK_CE(a, 12,13) TK_CE(a, 14,15) }
__device__ __forceinline__ void merge16(f32x16& a, const f32x16& b) {
#pragma unroll
  for (int i = 0; i < 16; ++i) a[i] = vmax(a[i], b[15 - i]);
  bitonic16(a);
}
__device__ __forceinline__ float packf(float v, unsigned mask, unsigned code) { return __uint_as_float((__float_as_uint(v) & mask) | code); }

__device__ __forceinline__ void stage_subkeys(const float* __restrict__ sk, char* lds, int tid) {
  for (int e = tid; e < 2 * 128 * 16; e += 512) { const int row = e >> 4, ch = e & 15;
    const float4 a = *(const float4*)(sk + (size_t)row * 128 + ch * 8), b = *(const float4*)(sk + (size_t)row * 128 + ch * 8 + 4);
    u32x4 w = {pg8::cvt_pk_bf16(a.x, a.y), pg8::cvt_pk_bf16(a.z, a.w), pg8::cvt_pk_bf16(b.x, b.y), pg8::cvt_pk_bf16(b.z, b.w)};
    *(u32x4*)(lds + (row >> 7) * 32768 + AT_KSWZ(row & 127, ch * 16)) = w; }
}
__device__ __forceinline__ void topk_task(int tg, int h, const bf16_t* __restrict__ qp, char* lds, int wid, int lane, int* pidx, float* pgate) {
  const int r32 = lane & 31, hi = lane >> 5;
  f32x16 L[2];
#pragma unroll
  for (int p = 0; p < 2; ++p) {
    f32x16 acc[4] = {};
    const bf16_t* qrow = qp + (size_t)(tg * 32 + r32) * DM + h * 256 + p * 128 + hi * 8;
    const char* skb = lds + p * 32768;
#pragma unroll
    for (int ks = 0; ks < 8; ++ks) { const bf16x8 qf = *reinterpret_cast<const bf16x8*>(qrow + ks * 16); const int cb = (ks * 16 + hi * 8) * 2;
#pragma unroll
      for (int kb = 0; kb < 4; ++kb) { const bf16x8 af = *reinterpret_cast<const bf16x8*>(skb + AT_KSWZ(kb * 32 + r32, cb)); acc[kb] = __builtin_amdgcn_mfma_f32_32x32x16_bf16(af, qf, acc[kb], 0, 0, 0); } }
#pragma unroll
    for (int kb = 0; kb < 4; ++kb)
#pragma unroll
      for (int r = 0; r < 16; ++r) acc[kb][r] = packf(acc[kb][r], 0xFFFFFF80u, (unsigned)(kb * 32 + (r & 3) + 8 * (r >> 2) + 4 * hi));
    sort16(acc[0]); sort16(acc[1]); sort16(acc[2]); sort16(acc[3]);
    merge16(acc[0], acc[1]); merge16(acc[2], acc[3]); merge16(acc[0], acc[2]);
    f32x16 pr;
#pragma unroll
    for (int i = 0; i < 16; ++i) { auto rr = __builtin_amdgcn_permlane32_swap(__float_as_uint(acc[0][i]), __float_as_uint(acc[0][i]), false, false); pr[i] = __uint_as_float(hi ? rr[0] : rr[1]); }
    merge16(acc[0], pr);
    L[p] = acc[0];
  }
  unsigned* scr = (unsigned*)(lds + OFF_SCR + wid * 8192) + lane;
#pragma unroll
  for (int i = 0; i < 16; ++i) { scr[64 * i] = __float_as_uint(L[0][i]) & 127u; scr[64 * (16 + i)] = __float_as_uint(L[1][i]) & 127u; }
  const f32x16& a = L[0]; const f32x16& b = L[1];
  const float ninf = -__builtin_inff();
  f32x16 G1, G2, G3, G4;
#define TK_C(i, j) packf(a[i] + b[j], 0xFFFFFF00u, (unsigned)((i) << 4 | (j)))
#pragma unroll
  for (int j = 0; j < 16; ++j) G1[j] = TK_C(0, j);
#pragma unroll
  for (int j = 0; j < 8; ++j) { G2[j] = TK_C(1, j); G2[8 + j] = TK_C(15 - j, 0); }
  G3[0] = TK_C(2, 0); G3[1] = TK_C(2, 1); G3[2] = TK_C(2, 2); G3[3] = TK_C(2, 3); G3[4] = TK_C(2, 4); G3[5] = TK_C(3, 0); G3[6] = TK_C(3, 1); G3[7] = TK_C(3, 2); G3[8] = TK_C(3, 3);
  G3[9] = TK_C(4, 0); G3[10] = TK_C(4, 1); G3[11] = TK_C(4, 2); G3[12] = TK_C(5, 0); G3[13] = TK_C(5, 1); G3[14] = TK_C(6, 0); G3[15] = TK_C(6, 1);
  G4[0] = TK_C(7, 0); G4[1] = TK_C(7, 1);
#pragma unroll
  for (int j = 2; j < 16; ++j) G4[j] = ninf;
#undef TK_C
  bitonic16(G2); sort16(G3); TK_CE(G4, 0, 1);
  merge16(G1, G2); merge16(G3, G4); merge16(G1, G3);
  asm volatile("s_waitcnt lgkmcnt(0)" ::: "memory");
  float e[16]; float sum = 0.f; int idx[16];
#pragma unroll
  for (int i = 0; i < 16; ++i) { e[i] = __builtin_amdgcn_exp2f((G1[i] - G1[0]) * 1.4426950408889634f); sum += e[i];
    const unsigned code = __float_as_uint(G1[i]) & 255u; idx[i] = (int)(scr[64 * (code >> 4)] * 128u + scr[64 * (16 + (code & 15u))]); }
  const float rs = __builtin_amdgcn_rcpf(sum);
  const size_t o = ((size_t)(tg * 32 + r32) * 8 + h) * 16;
  if (hi == 0) {
#pragma unroll
    for (int q = 0; q < 4; ++q) *(int4*)(pidx + o + q * 4) = make_int4(idx[q * 4], idx[q * 4 + 1], idx[q * 4 + 2], idx[q * 4 + 3]);
  } else {
#pragma unroll
    for (int q = 0; q < 4; ++q) *(float4*)(pgate + o + q * 4) = make_float4(e[q * 4] * rs, e[q * 4 + 1] * rs, e[q * 4 + 2] * rs, e[q * 4 + 3] * rs);
  }
}
}

#define XB_TMO      128
#define XB_XCNT(j)  (256  + 64 * (j))
#define XB_XSUB(j)  (1280 + 64 * (j))
#define XB_XGEN(j)  (2304 + 64 * (j))
#define XB_TOP      3328
#define XB_TOPGEN   3392
#define XB_SPIN_CAP (1u << 20)
#define XB_LAS __attribute__((address_space(3)))
__device__ __forceinline__ unsigned xb_ld(unsigned* p)              { return __hip_atomic_load(p, __ATOMIC_RELAXED, __HIP_MEMORY_SCOPE_AGENT); }
__device__ __forceinline__ unsigned xb_add(unsigned* p, unsigned v) { return __hip_atomic_fetch_add(p, v, __ATOMIC_RELAXED, __HIP_MEMORY_SCOPE_AGENT); }
__device__ __forceinline__ unsigned xb_xcc_id() { return (unsigned)__builtin_amdgcn_s_getreg((3 << 11) | 20) & 0xFu; }
#define XB_SPIN(cond, bar) do { unsigned _sp = 0; while (cond) { __builtin_amdgcn_s_sleep(1); \
    if ((++_sp & 255u) == 0u) { if (xb_ld(&(bar)[XB_TMO])) break; if (_sp > XB_SPIN_CAP) { atomicAdd(&(bar)[XB_TMO], 1u); break; } } } } while (0)
struct XcdBarrier { unsigned* bar; unsigned x; volatile XB_LAS unsigned* st; };
__device__ __forceinline__ XcdBarrier xcd_barrier_post(unsigned* bar, volatile XB_LAS unsigned* st) {
    XcdBarrier b; b.bar = bar; b.x = xb_xcc_id(); b.st = st;
    if (threadIdx.x == 0) (void)xb_add(&bar[XB_XCNT(b.x)], 1u);
    return b;
}
__device__ __forceinline__ void xcd_barrier_complete(unsigned* bar, unsigned x, unsigned& nloc, unsigned& nx) {
    const unsigned G = gridDim.x * gridDim.y * gridDim.z;
    unsigned sum, cnt, mine, sp = 0u;
    for (;;) {
        sum = 0u; cnt = 0u; mine = 0u;
#pragma unroll
        for (unsigned j = 0; j < 16; ++j) { const unsigned c = xb_ld(&bar[XB_XCNT(j)]); sum += c; cnt += (c > 0u) ? 1u : 0u; mine = (j == x) ? c : mine; }
        if (sum == G) break;
        __builtin_amdgcn_s_sleep(1);
        if ((++sp & 255u) == 0u) { if (xb_ld(&bar[XB_TMO])) break; if (sp > XB_SPIN_CAP) { atomicAdd(&bar[XB_TMO], 1u); break; } }
    }
    nloc = mine > 0u ? mine : 1u; nx = cnt > 0u ? cnt : 1u;
}
__device__ __forceinline__ void xcd_barrier(const XcdBarrier& b) {
    asm volatile("s_waitcnt vmcnt(0)" ::: "memory");
    __syncthreads();
    if (threadIdx.x == 0) {
        unsigned* bar = b.bar;
        __builtin_amdgcn_s_waitcnt(0);
        unsigned nloc = b.st[0], nx = b.st[1];
        if (nloc == 0u) { xcd_barrier_complete(bar, b.x, nloc, nx); b.st[0] = nloc; b.st[1] = nx; }
        const unsigned old = xb_add(&bar[XB_XSUB(b.x)], 1u);
        const unsigned gen = old / nloc;
        if (old + 1u == (gen + 1u) * nloc) {
            __builtin_amdgcn_fence(__ATOMIC_RELEASE, "agent");
            asm volatile("s_waitcnt vmcnt(0)" ::: "memory");
            const unsigned og = xb_add(&bar[XB_TOP], 1u);
            const unsigned tg = og / nx;
            if (og + 1u == (tg + 1u) * nx) xb_add(&bar[XB_TOPGEN], 1u);
            else XB_SPIN(xb_ld(&bar[XB_TOPGEN]) == tg, bar);
            __builtin_amdgcn_fence(__ATOMIC_ACQUIRE, "agent");
            xb_add(&bar[XB_XGEN(b.x)], 1u);
            asm volatile("s_waitcnt vmcnt(0)" ::: "memory");
        } else {
            XB_SPIN(xb_ld(&bar[XB_XGEN(b.x)]) == gen, bar);
            __builtin_amdgcn_fence(__ATOMIC_ACQUIRE, "agent");
            asm volatile("s_waitcnt vmcnt(0)" ::: "memory");
        }
    }
    __syncthreads();
}

__device__ __forceinline__ void p0_ada_partial(int b, char* lds, const float* __restrict__ c, const float* __restrict__ cctx, const float* __restrict__ wmod, float* part) {
  int tid = threadIdx.x; asm volatile("" : "+v"(tid));
  float* sl = (float*)lds;
  const int slab = b >> 3, chunk = b & 7, k0 = slab * 64;
  __syncthreads();
  if (tid < 128) { const int cond = tid >> 6, k = tid & 63; const float x = (cond ? cctx : c)[k0 + k]; sl[tid] = x / (1.0f + expf(-x)); }
  __syncthreads();
  if (tid < 384) {
    const int col = chunk * 1536 + tid * 4; float4 a0 = {0.f, 0.f, 0.f, 0.f}, a1 = a0;
    const float* wp = wmod + (size_t)k0 * NMOD + col;
#pragma unroll 8
    for (int k = 0; k < 64; ++k) { const float4 w = *(const float4*)(wp + (size_t)k * NMOD); const float s0 = sl[k], s1 = sl[64 + k];
      a0.x += s0 * w.x; a0.y += s0 * w.y; a0.z += s0 * w.z; a0.w += s0 * w.w; a1.x += s1 * w.x; a1.y += s1 * w.y; a1.z += s1 * w.z; a1.w += s1 * w.w; }
    *(float4*)(part + ((size_t)slab * 2 + 0) * NMOD + col) = a0; *(float4*)(part + ((size_t)slab * 2 + 1) * NMOD + col) = a1;
  }
}
__device__ __forceinline__ void p1_modulate(int b, int nb, char* lds, const float* __restrict__ part, const float* __restrict__ bmod, const float* __restrict__ g1, const float* __restrict__ x, const float* __restrict__ ctx,
                                            float* mod, bf16_t* hx) {
  int tid = threadIdx.x; asm volatile("" : "+v"(tid));
  const int wid = tid >> 6, lane = tid & 63;
  float* vA = (float*)lds;
  float* vB = vA + 2 * DM;
  __syncthreads();
  const int ncond = (b < 32) ? 2 : 1;
  for (int e = tid; e < ncond * DM; e += 512) { const int cond = e >> 11, col = e & (DM - 1); float sh = bmod[col], sc = bmod[DM + col];
    for (int s = 0; s < 32; ++s) { sh += part[((size_t)s * 2 + cond) * NMOD + col]; sc += part[((size_t)s * 2 + cond) * NMOD + DM + col]; }
    vA[cond * DM + col] = g1[col] * (1.0f + sc); vB[cond * DM + col] = sh; }
  if (tid < 96) { const int cond = tid / 48; for (int col = b * 48 + tid % 48; col < NMOD; col += nb * 48) { float v = bmod[col];
      for (int s = 0; s < 32; ++s) v += part[((size_t)s * 2 + cond) * NMOD + col];
      mod[cond * NMOD + col] = v; } }
  __syncthreads();
  for (int r = b * 8 + wid; r < TOT; r += nb * 8) {
    const bool isx = r < SEQ; const float* xr = isx ? x + (size_t)r * DM : ctx + (size_t)(r - SEQ) * DM; const float* a = vA + (isx ? 0 : DM); const float* bb = vB + (isx ? 0 : DM);
    float v[32]; float ss = 0.f;
#pragma unroll
    for (int q = 0; q < 8; ++q) { const float4 t = *(const float4*)(xr + q * 256 + lane * 4); v[q * 4] = t.x; v[q * 4 + 1] = t.y; v[q * 4 + 2] = t.z; v[q * 4 + 3] = t.w; ss += t.x * t.x + t.y * t.y + t.z * t.z + t.w * t.w; }
    ss = wave_sum(ss); const float rinv = rsqrtf(ss * (1.0f / DM) + 1e-6f);
#pragma unroll
    for (int q = 0; q < 8; ++q) { const int c0 = q * 256 + lane * 4; const float4 av = *(const float4*)(a + c0), bv = *(const float4*)(bb + c0);
      int o = 0; o = __builtin_amdgcn_cvt_pk_fp8_f32(v[q * 4] * rinv * av.x + bv.x, v[q * 4 + 1] * rinv * av.y + bv.y, o, false); o = __builtin_amdgcn_cvt_pk_fp8_f32(v[q * 4 + 2] * rinv * av.z + bv.z, v[q * 4 + 3] * rinv * av.w + bv.w, o, true);
      *(int*)((unsigned char*)hx + (size_t)r * DM + c0) = o; }
  }
}
__device__ __forceinline__ void p0_small(int b, const float* lq1, const float* lk1, const float* lq2, const float* lk2, float* misc, float* rope, float* rcos, float* rsin) {
  int tid = threadIdx.x; asm volatile("" : "+v"(tid));
  if (b == 0 && tid == 0) { float a = 0.f, c = 0.f; for (int i = 0; i < 64; ++i) { a += lq1[i] * lk1[i]; c += lq2[i] * lk2[i]; } misc[0] = expf(a) - expf(c) + 0.2f; }
  if (b == 1) { for (int e = tid; e < 256 * 16; e += 512) { const int pos = e >> 4, i = e & 15; const float fr = powf(10000.0f, -(float)i / 16.0f); const float ang = (float)pos * fr;
      const float cs = cosf(ang), sn = sinf(ang); rope[e * 2] = cs; rope[e * 2 + 1] = sn; rcos[e] = cs; rsin[e] = sn; } }
}

#include <hip/hip_cooperative_groups.h>
namespace cg = cooperative_groups;

struct Params {
  const float *x, *c, *ctx, *cctx, *wmod, *bmod, *g1, *g2, *win, *lq1, *lk1, *lq2, *lk2, *subln, *rpb, *wa, *wb, *wo, *wq, *subkeys, *U, *V, *fg;
  float* out; WS w;
};

constexpr int MEGA_LDS = 163840;

__global__ __launch_bounds__(512, 2) void mega(Params p) {
  extern __shared__ __attribute__((aligned(16))) char smem[];
  cg::grid_group grid = cg::this_grid();
#define HALF_TID int t_ = threadIdx.x; asm volatile("" : "+v"(t_)); const int half = t_ >> 8, tid = t_ & 255; char* lds = smem + half * 32768; (void)lds; (void)tid;
  const int nb = gridDim.x; const WS& w = p.w;
  volatile XB_LAS unsigned* xst = (volatile XB_LAS unsigned*)(smem + MEGA_LDS - 16);
  if (threadIdx.x == 0) { xst[0] = 0u; xst[1] = 0u; }
  __syncthreads();
  const XcdBarrier xb = xcd_barrier_post(w.bar, xst);
  if (w.bar == nullptr) grid.sync();
  const float* modc = w.mod; const float* modx = w.mod + NMOD;
#define VLOOP(NB) for (int vb = blockIdx.x * 2 + half; vb < (NB); vb += nb * 2)
  PG8_LAS unsigned char* glds = (PG8_LAS unsigned char*)smem;
  for (int b2 = blockIdx.x; b2 < 256; b2 += nb) p0_ada_partial(b2, smem, p.c, p.cctx, p.wmod, w.part);
  p0_small(blockIdx.x, p.lq1, p.lk1, p.lq2, p.lk2, w.misc, w.rope, w.rcos, w.rsin);
  for (int tile = blockIdx.x; tile < 2560; tile += nb) prep_transpose8(tile, smem, p.win, NIN, DM, NIN, (unsigned char*)w.wt_in, DM, 0);
  xcd_barrier(xb);
  p1_modulate(blockIdx.x, nb, smem, w.part, p.bmod, p.g1, p.x, p.ctx, w.mod, w.hx);
  xcd_barrier(xb);
  if ((blockIdx.x >> 3) & 1) { __builtin_amdgcn_s_sleep(127); __builtin_amdgcn_s_sleep(127); }
  { pg8::EpiInProj8 e; e.w = w; e.rcos = w.rcos; e.rsin = w.rsin; pg8::InProjOrder S; S.init(nb, blockIdx.x);
    pg8::Gemm g; g.A = w.hx; g.Bt = w.wt_in; g.M = TOT; g.N = NIN; g.K = DM; pg8::gemm_phase8(glds, g, S, e); }
  if (blockIdx.x >= 16 || nb <= 16) { const int b3 = nb > 16 ? (int)blockIdx.x - 16 : (int)blockIdx.x, n3 = nb > 16 ? nb - 16 : nb;
    for (int tile = 2560 + b3; tile < 4096; tile += n3) {
      if (tile < 2816) prep_transpose(tile - 2560, smem, p.wa, DM, 1024, DM, w.wt_ab, DM, 0);
      else if (tile < 3072) prep_transpose(tile - 2816, smem, p.wb, DM, 1024, DM, w.wt_ab, DM, 1024);
      else if (tile < 3584) prep_transpose(tile - 3072, smem, p.wo, DM, DM, DM, w.wt_o, DM, 0);
      else prep_transpose(tile - 3584, smem, p.wq, DM, DM, DM, w.wt_q, DM, 0);
    }
    int t2 = threadIdx.x; asm volatile("" : "+v"(t2)); const int wv = t2 >> 6, ln = t2 & 63;
    for (int row = b3 * 8 + wv; row < 16384; row += n3 * 8) {
      float va[32], vb[32]; p6::quant_load_nat(p.U + (size_t)row * DM, va, ln); p6::quant_load(p.V + (size_t)row * DM, vb, ln);
      p6::quant_fin4(va, w.u8 + (size_t)row * 1024, w.uscale + row, ln); p6::quant_fin4b(vb, w.v8 + (size_t)row * 1088, ln); } }
  xcd_barrier(xb);
  { const float lam = w.misc[0]; const int hh = blockIdx.x & 7, sub = blockIdx.x >> 3, nsub = nb >> 3;
    for (int qb = sub; qb < 64; qb += nsub) da::diff_attn_item(hh, qb, w.qa, w.ka, w.va, p.subln, lam, w.kmax, w.outa, smem);
    for (int rb = sub; rb < 64; rb += nsub) da::na_item8(hh, rb, w.qb, w.kb, w.vb, p.rpb, w.outb, smem); }
  xcd_barrier(xb);
  if ((blockIdx.x >> 3) & 1) __builtin_amdgcn_s_sleep(127);
  { pg8::EpiMerge1M e; e.sga = w.sga; e.sgb = w.sgb; e.out = w.mrg; pg8::StaticOrder S; S.init(SEQ, DM, nb, blockIdx.x);
    pg8::Gemm g; g.A = w.outa; g.Bt = w.wt_ab; g.M = SEQ; g.N = DM; g.K = DM; pg8::gemm_phase(glds, g, S, e); }
  xcd_barrier(xb);
  if ((blockIdx.x >> 3) & 1) __builtin_amdgcn_s_sleep(127);
  { pg8::EpiResidM e; e.x = p.x; e.gt = modc + 2 * DM; e.out = p.out; pg8::StaticOrder S; S.init(SEQ, DM, nb, blockIdx.x);
    pg8::Gemm g; g.A = w.mrg; g.Bt = w.wt_o; g.M = SEQ; g.N = DM; g.K = DM; pg8::gemm_phase(glds, g, S, e); }
  xcd_barrier(xb);
  { HALF_TID g_modulate(blockIdx.x * 2 + half, nb * 2, tid, p.out, SEQ, p.g2, modc + 3 * DM, modc + 4 * DM, w.hx, (unsigned char*)w.sgb); }
  xcd_barrier(xb);
  if ((blockIdx.x >> 3) & 1) __builtin_amdgcn_s_sleep(127);
  { pg8::EpiBf16M e; e.out = w.sga; e.ld = DM; pg8::StaticOrder S; S.init(SEQ, DM, nb, blockIdx.x);
    pg8::Gemm g; g.A = w.hx; g.Bt = w.wt_q; g.M = SEQ; g.N = DM; g.K = DM; pg8::gemm_phase(glds, g, S, e); }
  xcd_barrier(xb);
  int xrank = 0;
  { int t2 = threadIdx.x; asm volatile("" : "+v"(t2)); const int wv = __builtin_amdgcn_readfirstlane(t2 >> 6), ln = t2 & 63; const int hh = blockIdx.x & 7, sub = blockIdx.x >> 3;
    __syncthreads(); tk::stage_subkeys(p.subkeys + (size_t)hh * 32768, smem, t2); __syncthreads();
    if (t2 == 0) xrank = (int)atomicAdd(w.kmax + 32 + (xb.x & 7), 1u);
    for (int tg = sub * 8 + wv; tg < SEQ / 32; tg += (nb >> 3) * 8) tk::topk_task(tg, hh, w.sga, smem, wv, ln, w.pidx, w.pgate); }
  xcd_barrier(xb);
  { int t2 = threadIdx.x; asm volatile("" : "+v"(t2)); const int wv = __builtin_amdgcn_readfirstlane(t2 >> 6), ln = t2 & 63;
    float* actb = (float*)w.outa;
    __syncthreads(); if (t2 == 0) { bool even_ = true; for (int x_ = 0; x_ < 8; ++x_) even_ = even_ && (__hip_atomic_load(w.kmax + 32 + x_, __ATOMIC_RELAXED, __HIP_MEMORY_SCOPE_AGENT) == (unsigned)(nb >> 3));
      ((volatile int*)smem)[8192] = even_ ? (int)(xb.x & 7) : (int)(blockIdx.x & 7); ((volatile int*)smem)[8193] = even_ ? xrank : (int)(blockIdx.x >> 3); }
    __syncthreads(); const int sl_ = ((volatile int*)smem)[8192], rk_ = ((volatile int*)smem)[8193]; __syncthreads();
    p6::expert_u_slice(sl_, rk_ * 8 + wv, (nb >> 3) * 8, ln, smem + wv * 4096, (const unsigned char*)w.sgb, w.pidx, w.pgate, w.u8, w.uscale, actb);
    xcd_barrier(xb);
    p6::expert_v_tokens(blockIdx.x * 8 + wv, nb * 8, ln, p.out, modc, w.pidx, actb, w.v8, p.fg); }
#undef VLOOP
}

extern "C" void kernel_launch(void* const* d_in, const int* in_sizes, int n_in, void* d_out, int out_size, void* d_ws, size_t ws_size, hipStream_t stream) {
  Params p{};
  const float** f = (const float**)&p.x;
  for (int i = 0; i < 23; ++i) f[i] = (const float*)d_in[i];
  p.out = (float*)d_out; p.w = make_ws(d_ws);
  static int grid_blocks = 0;
  if (!grid_blocks) {
    int dev = 0, cus = 0, per_cu = 0;
    hipGetDevice(&dev); hipDeviceGetAttribute(&cus, hipDeviceAttributeMultiprocessorCount, dev);
    if (hipFuncSetAttribute((const void*)mega, hipFuncAttributeMaxDynamicSharedMemorySize, MEGA_LDS) != hipSuccess) fprintf(stderr, "hipFuncSetAttribute failed\n");
    hipOccupancyMaxActiveBlocksPerMultiprocessor(&per_cu, mega, 512, MEGA_LDS);
    if (per_cu < 1) fprintf(stderr, "occupancy query returned %d\n", per_cu);
    grid_blocks = cus * (per_cu >= 1 ? 1 : 0);
    if (ws_size < (size_t)620 * 1024 * 1024) fprintf(stderr, "ws_size small: %zu\n", ws_size);
  }
  hipMemsetAsync(p.w.bar, 0, (XCD_BAR_WORDS + 64) * 4, stream);
  void* args[] = {&p};
  hipError_t e = hipLaunchCooperativeKernel((const void*)mega, dim3(grid_blocks), dim3(512), args, MEGA_LDS, stream);
  if (e != hipSuccess) fprintf(stderr, "cooperative launch failed: %s (grid %d)\n", hipGetErrorString(e), grid_blocks);
}
```

```cpp
#include <hip/hip_runtime.h>
#include <cstdio>
#include <cstdint>

typedef unsigned short bf16_t;

#define DM 2048
#define SEQ 16384
#define CTXL 256
#define TOT (SEQ + CTXL)
#define NIN 10240
#define NMOD 12288
#define XCD_BAR_WORDS 3456

__device__ __forceinline__ float bf2f(bf16_t b) { return __uint_as_float(((unsigned)b) << 16); }
__device__ __forceinline__ bf16_t f2bf(float f) { unsigned u = __float_as_uint(f); u += 0x7FFFu + ((u >> 16) & 1u); return (bf16_t)(u >> 16); }
__device__ __forceinline__ float dpp_xor1(float v) { return __int_as_float(__builtin_amdgcn_update_dpp(0, __float_as_int(v), 0xB1, 0xF, 0xF, true)); }
__device__ __forceinline__ float dpp_xor2(float v) { return __int_as_float(__builtin_amdgcn_update_dpp(0, __float_as_int(v), 0x4E, 0xF, 0xF, true)); }
__device__ __forceinline__ float wave_sum(float v) { for (int o = 32; o >= 1; o >>= 1) v += __shfl_xor(v, o); return v; }
__device__ __forceinline__ float wave_max(float v) { for (int o = 32; o >= 1; o >>= 1) v = fmaxf(v, __shfl_xor(v, o)); return v; }
__device__ __forceinline__ float sigmoidf_(float x) { return 1.0f / (1.0f + __expf(-x)); }
__device__ __forceinline__ float gelu_tanh(float x) { const float u = 0.7978845608028654f * (x + 0.044715f * x * x * x); return 0.5f * x * (1.0f + tanhf(u)); }

struct WS {
  float* mod;
  float* misc;
  float* rope;
  bf16_t* hx;
  bf16_t* qa;
  bf16_t* ka;
  bf16_t* va;
  bf16_t* qb;
  bf16_t* kb;
  bf16_t* vb;
  bf16_t* sga;
  bf16_t* sgb;
  bf16_t* outa;
  bf16_t* outb;
  bf16_t* mrg;
  float* scores;
  int* pidx;
  float* pgate;
  float* rcos;
  float* rsin;
  unsigned long long* rowss; unsigned long long* bq; float* rinv;
  bf16_t* wt_in;
  bf16_t* wt_ab;
  bf16_t* wt_o;
  bf16_t* wt_q;
  unsigned char* u8; unsigned char* v8;
  float* uscale; float* vscale;
  unsigned* bar;
  float* part;
  unsigned* kmax;
};

static WS make_ws(void* d_ws) {
  char* p = (char*)d_ws; WS w; size_t o = 0;
  auto take = [&](size_t bytes) { char* r = p + o; o += (bytes + 255) / 256 * 256; return r; };
  w.bar = (unsigned*)take((XCD_BAR_WORDS + 64) * 4); w.kmax = w.bar + XCD_BAR_WORDS;
  w.part = (float*)take((size_t)32 * 2 * NMOD * 4);
  w.mod = (float*)take(2 * NMOD * 4); w.misc = (float*)take(256); w.rope = (float*)take(256 * 16 * 2 * 4);
  w.pidx = (int*)take((size_t)SEQ * 128 * 4); w.pgate = (float*)take((size_t)SEQ * 128 * 4);
  w.hx = (bf16_t*)take((size_t)TOT * DM * 2);
  w.outa = (bf16_t*)take((size_t)SEQ * 2048 * 2); w.outb = w.outa + 1024;
  w.rcos = (float*)take(256 * 16 * 4); w.rsin = (float*)take(256 * 16 * 4);
  w.wt_in = (bf16_t*)take((size_t)NIN * DM * 2); w.wt_ab = (bf16_t*)take((size_t)DM * DM * 2); w.wt_o = (bf16_t*)take((size_t)DM * DM * 2); w.wt_q = (bf16_t*)take((size_t)DM * DM * 2);
  w.u8 = (unsigned char*)take((size_t)16384 * DM); w.v8 = (unsigned char*)take((size_t)16384 * DM); w.uscale = (float*)take(16384 * 8); w.vscale = w.uscale;
  w.qa = (bf16_t*)take((size_t)SEQ * 1024 * 2); w.ka = (bf16_t*)take((size_t)TOT * 1024 * 2);
  w.va = (bf16_t*)take((size_t)TOT * 1024 * 2); w.qb = (bf16_t*)take((size_t)SEQ * 1024 * 2);
  w.kb = (bf16_t*)take((size_t)TOT * 1024 * 2); w.vb = (bf16_t*)take((size_t)TOT * 1024 * 2);
  w.sga = (bf16_t*)take((size_t)SEQ * DM * 2); w.sgb = (bf16_t*)take((size_t)SEQ * DM * 2);
  w.mrg = w.qa;
  w.scores = (float*)w.va;
  w.rowss = (unsigned long long*)take((size_t)(SEQ + 2048) * 8); w.bq = w.rowss + SEQ; w.rinv = (float*)take((size_t)SEQ * 4);
  return w;
}

__device__ __forceinline__ void g_modulate(int vb, int nvb, int tid, const bf16_t* __restrict__ in, int nrows, const float* __restrict__ g, const float* __restrict__ shift, const float* __restrict__ scale, bf16_t* out, unsigned char* out8 = nullptr) {
  const int wid = tid >> 6, lane = tid & 63;
  for (int r = vb * 4 + wid; r < nrows; r += nvb * 4) {
    const bf16_t* x = in + (size_t)r * DM; float v[32]; float ss = 0.f;
#pragma unroll
    for (int q = 0; q < 8; ++q) { const uint2 u = *(const uint2*)(x + q * 256 + lane * 4); float4 t; t.x = __uint_as_float(u.x << 16); t.y = __uint_as_float(u.x & 0xffff0000u); t.z = __uint_as_float(u.y << 16); t.w = __uint_as_float(u.y & 0xffff0000u);
      v[q * 4] = t.x; v[q * 4 + 1] = t.y; v[q * 4 + 2] = t.z; v[q * 4 + 3] = t.w; ss += t.x * t.x + t.y * t.y + t.z * t.z + t.w * t.w; }
    ss = wave_sum(ss); const float rinv = rsqrtf(ss * (1.0f / DM) + 1e-6f);
#pragma unroll
    for (int q = 0; q < 8; ++q) { const int c0 = q * 256 + lane * 4; ushort4 o; bf16_t* op = (bf16_t*)&o;
      float hv[4];
#pragma unroll
      for (int j = 0; j < 4; ++j) { hv[j] = v[q * 4 + j] * rinv * g[c0 + j] * (1.0f + scale[c0 + j]) + shift[c0 + j]; op[j] = f2bf(hv[j]); }
      *(ushort4*)(out + (size_t)r * DM + c0) = o;
      if (out8) { int pk = 0; pk = __builtin_amdgcn_cvt_pk_fp8_f32(hv[0] * 8.0f, hv[1] * 8.0f, pk, false); pk = __builtin_amdgcn_cvt_pk_fp8_f32(hv[2] * 8.0f, hv[3] * 8.0f, pk, true); *(unsigned*)(out8 + (size_t)r * DM + c0) = (unsigned)pk; } }
  }
}

namespace pg8 {
#define PG8_LAS __attribute__((address_space(3)))
typedef short bf16x8 __attribute__((ext_vector_type(8)));
typedef float f32x4 __attribute__((ext_vector_type(4)));
typedef unsigned u32x4 __attribute__((ext_vector_type(4)));
typedef int i32x4 __attribute__((ext_vector_type(4)));
typedef int i32x8 __attribute__((ext_vector_type(8)));
typedef float f32x16 __attribute__((ext_vector_type(16)));
__host__ __device__ __forceinline__ int perm32f8(int rho) { return 16 * ((rho >> 2) & 1) + (rho & 3) + 4 * (rho >> 3); }
constexpr int BM = 256, BK = 64, HALF = 128, HTB = HALF * BK * 2, STAGE_BYTES = 8 * HTB, NXCD = 8, WGM = 8;
__host__ __device__ __forceinline__ int lds_byte(int r, int c) { const int st = (r >> 4) * 2 + (c >> 5), rr = r & 15, cc = c & 31, ob = rr * 64 + cc * 2; return st * 1024 + (ob ^ (((ob >> 9) & 1) << 5)); }
__host__ __device__ __forceinline__ void stage_rc(int b, int& R, int& C) { const int st = b / 1024, sb = b % 1024, swz = sb ^ (((sb >> 9) & 1) << 5); R = (st >> 1) * 16 + swz / 64; C = (st & 1) * 32 + (swz % 64) / 2; }
__host__ __device__ __forceinline__ int perm32(int rho) { const int n = rho >> 4, i = rho & 15; return 8 * (i >> 2) + 4 * n + (i & 3); }
struct Unit { int pm, pn; };
struct Gemm { const bf16_t* A; const bf16_t* Bt; int M, N, K; };
__device__ __forceinline__ unsigned cvt_pk_bf16(float lo, float hi) { unsigned r; asm volatile("v_cvt_pk_bf16_f32 %0, %1, %2" : "=v"(r) : "v"(lo), "v"(hi)); return r; }

struct StaticOrder {
    int nM, nN, nwg, G, c;
    __device__ void init(int M, int N, int G_, int c_) { nM = M / BM; nN = N / BM; nwg = nM * nN; G = G_; c = c_; }
    __device__ bool next(int i, Unit& u) const {
        const long L = (long)i * G + c; if (L >= nwg) return false;
        int wgid = (int)L; { const int q = nwg / NXCD, r = nwg % NXCD, xcd = wgid % NXCD, off = wgid / NXCD; wgid = (xcd < r ? xcd * (q + 1) : r * (q + 1) + (xcd - r) * q) + off; }
        const int nig = WGM * nN, gid = wgid / nig, fm = gid * WGM, gsz = (nM - fm) < WGM ? (nM - fm) : WGM;
        u.pm = fm + ((wgid % nig) % gsz); u.pn = (wgid % nig) / gsz; return true;
    }
};
struct InProjOrder {
    StaticOrder s;
    __device__ void init(int G_, int c_) { s.init(SEQ, NIN, G_, c_); }
    __device__ bool next(int i, Unit& u) const {
        const long L = (long)i * s.G + s.c;
        if (L < s.nwg) return s.next(i, u);
        const int j = (int)(L - s.nwg); if (j >= 16) return false;
        u.pm = 64; u.pn = j < 8 ? 4 + j : 8 + j; return true;
    }
};

template <class Epi, class Sched>
__device__ __forceinline__ void gemm_phase(PG8_LAS unsigned char* lds, const Gemm g, const Sched& S, const Epi& E) {
    int tid = threadIdx.x; asm volatile("" : "+v"(tid));
    const int wid = __builtin_amdgcn_readfirstlane(tid >> 6), lane = tid & 63, wr = wid >> 2, wc = wid & 3, fr = lane & 15, fq = lane >> 4;
    const int K = g.K, nt = K / BK;
    unsigned voffA[2], voffB[2];
#pragma unroll
    for (int i = 0; i < 2; ++i) { int R, C; stage_rc(tid * 16 + i * 8192, R, C); const int Rb = Epi::PERM ? ((R & ~31) + perm32(R & 31)) : R;
        voffA[i] = (unsigned)(R * K + C) * 2u; voffB[i] = (unsigned)(Rb * K + C) * 2u; }
    const size_t kstep = (size_t)(BK * 2);
    const size_t hstep = (size_t)HALF * K * 2;
    const size_t tstep = 2 * hstep;
    const unsigned ldsw = (unsigned)wid * 1024u;
    const int aoff = lds_byte(wr * 64 + fr, fq * 8), boff = lds_byte(wc * 32 + fr, fq * 8);
#define PG8_SA(b, h) (((b) * 2 + (h)) * HTB)
#define PG8_SB(b, h) ((4 + (b) * 2 + (h)) * HTB)
#define PG8_STAGE(bufoff, gbase, voff) do { _Pragma("unroll") for (int _i = 0; _i < 2; ++_i) \
        __builtin_amdgcn_global_load_lds((const unsigned*)((const char*)(gbase) + (voff)[_i]), (PG8_LAS unsigned*)(lds + (bufoff) + ldsw + _i * 8192), 16, 0, 0); } while (0)
#define PG8_LDA(dst, b, h) do { _Pragma("unroll") for (int m = 0; m < 4; ++m) _Pragma("unroll") for (int k = 0; k < 2; ++k) dst[m][k] = *(const PG8_LAS bf16x8*)(lds + PG8_SA(b, h) + aoff + m * 2048 + k * 1024); } while (0)
#define PG8_LDB(dst, b, h) do { _Pragma("unroll") for (int n = 0; n < 2; ++n) _Pragma("unroll") for (int k = 0; k < 2; ++k) dst[n][k] = *(const PG8_LAS bf16x8*)(lds + PG8_SB(b, h) + boff + n * 2048 + k * 1024); } while (0)
#define PG8_MMA(ai, bj, At, Bt) do { __builtin_amdgcn_s_setprio(1); _Pragma("unroll") for (int m = 0; m < 4; ++m) _Pragma("unroll") for (int n = 0; n < 2; ++n) _Pragma("unroll") for (int k = 0; k < 2; ++k) \
        acc[ai][bj][m][n] = __builtin_amdgcn_mfma_f32_16x16x32_bf16(Bt[n][k], At[m][k], acc[ai][bj][m][n], 0, 0, 0); __builtin_amdgcn_s_setprio(0); } while (0)
#define PG8_WAIT_V(n) asm volatile("s_waitcnt vmcnt(" #n ")" ::: "memory")
#define PG8_WAIT_L(n) asm volatile("s_waitcnt lgkmcnt(" #n ")" ::: "memory")
#define PG8_BAR __builtin_amdgcn_s_barrier()
#define PG8_SCHED __builtin_amdgcn_sched_barrier(0)
#define PG8_KBODY \
            const bool last = (t == nt - 2); \
            const char* a1 = cA + (size_t)(t + 1) * kstep; \
            const char* a2 = last ? nA : cA + (size_t)(t + 2) * kstep; const char* b2 = last ? nB : cB + (size_t)(t + 2) * kstep; \
            const char* a3 = a2 + kstep; const char* b3 = b2 + kstep; \
            PG8_LDB(B0, 0, 0); PG8_SCHED; PG8_LDA(At, 0, 0); PG8_STAGE(PG8_SA(1, 1), a1 + hstep, voffA); \
            PG8_WAIT_L(8); PG8_BAR; PG8_WAIT_L(0); PG8_MMA(0, 0, At, B0); PG8_BAR; PG8_SCHED; \
            PG8_LDB(B1, 0, 1); PG8_STAGE(PG8_SB(0, 0), b2, voffB); \
            PG8_BAR; PG8_WAIT_L(0); PG8_MMA(0, 1, At, B1); PG8_BAR; \
            PG8_LDA(At, 0, 1); PG8_STAGE(PG8_SA(0, 0), a2, voffA); \
            PG8_BAR; PG8_WAIT_L(0); PG8_MMA(1, 0, At, B0); PG8_BAR; PG8_SCHED; \
            PG8_STAGE(PG8_SB(0, 1), b2 + hstep, voffB); \
            PG8_WAIT_V(6); PG8_BAR; PG8_MMA(1, 1, At, B1); PG8_BAR; \
            PG8_LDB(B0, 1, 0); PG8_SCHED; PG8_LDA(At, 1, 0); PG8_STAGE(PG8_SA(0, 1), a2 + hstep, voffA); \
            PG8_WAIT_L(8); PG8_BAR; PG8_WAIT_L(0); PG8_MMA(0, 0, At, B0); PG8_BAR; PG8_SCHED; \
            PG8_LDB(B1, 1, 1); PG8_STAGE(PG8_SB(1, 0), b3, voffB); \
            PG8_BAR; PG8_WAIT_L(0); PG8_MMA(0, 1, At, B1); PG8_BAR; \
            PG8_LDA(At, 1, 1); PG8_STAGE(PG8_SA(1, 0), a3, voffA); \
            PG8_BAR; PG8_WAIT_L(0); PG8_MMA(1, 0, At, B0); PG8_BAR; PG8_SCHED; \
            PG8_STAGE(PG8_SB(1, 1), b3 + hstep, voffB); \
            PG8_WAIT_V(6); PG8_BAR; PG8_MMA(1, 1, At, B1); PG8_BAR;
    Unit cur, nxt; int ui = 0;
    if (!S.next(0, cur)) return;
    f32x4 acc[2][2][4][2];
#pragma unroll
    for (int a = 0; a < 2; ++a)
#pragma unroll
        for (int b = 0; b < 2; ++b)
#pragma unroll
            for (int m = 0; m < 4; ++m)
#pragma unroll
                for (int n = 0; n < 2; ++n) acc[a][b][m][n] = (f32x4){0.f, 0.f, 0.f, 0.f};
    bf16x8 At[4][2], B0[2][2], B1[2][2];
    const char* cA = (const char*)g.A + (size_t)cur.pm * tstep; const char* cB = (const char*)g.Bt + (size_t)cur.pn * tstep;
    PG8_STAGE(PG8_SB(0, 0), cB, voffB); PG8_STAGE(PG8_SA(0, 0), cA, voffA); PG8_STAGE(PG8_SB(0, 1), cB + hstep, voffB); PG8_STAGE(PG8_SA(0, 1), cA + hstep, voffA);
    if (wr == 1) PG8_BAR;
    PG8_WAIT_V(4); PG8_BAR;
    PG8_STAGE(PG8_SB(1, 0), cB + kstep, voffB); PG8_STAGE(PG8_SA(1, 0), cA + kstep, voffA); PG8_STAGE(PG8_SB(1, 1), cB + hstep + kstep, voffB);
    PG8_WAIT_V(6); PG8_BAR;
    for (;;) {
        const bool has_next = S.next(ui + 1, nxt);
        const char* nA = has_next ? (const char*)g.A + (size_t)nxt.pm * tstep : cA; const char* nB = has_next ? (const char*)g.Bt + (size_t)nxt.pn * tstep : cB;
        if constexpr (Epi::MID_T > 0) {
            for (int t = 0; t < Epi::MID_T; t += 2) { PG8_KBODY }
            E.mid(acc, cur, wr, wc, fr, fq);
            for (int t = Epi::MID_T; t < nt; t += 2) { PG8_KBODY }
        } else {
            for (int t = 0; t < nt; t += 2) { PG8_KBODY }
        }
        E(acc, cur, wr, wc, fr, fq);
        if (!has_next) break;
#pragma unroll
        for (int a = 0; a < 2; ++a)
#pragma unroll
            for (int b = 0; b < 2; ++b)
#pragma unroll
                for (int m = 0; m < 4; ++m)
#pragma unroll
                    for (int n = 0; n < 2; ++n) acc[a][b][m][n] = (f32x4){0.f, 0.f, 0.f, 0.f};
        cur = nxt; cA = nA; cB = nB; ++ui;
    }
    PG8_WAIT_V(0);
    if (wr == 0) PG8_BAR;
    PG8_BAR;
#undef PG8_KBODY
#undef PG8_SA
#undef PG8_SB
#undef PG8_STAGE
#undef PG8_LDA
#undef PG8_LDB
#undef PG8_MMA
#undef PG8_WAIT_V
#undef PG8_WAIT_L
#undef PG8_BAR
#undef PG8_SCHED
}

struct EpiInProjM {
    static constexpr bool PERM = true; static constexpr int MID_T = 0;
    WS w; const float* rcos; const float* rsin;
    static constexpr float QC = 0.125f * 1.4426950408889634f;
    __device__ __forceinline__ void operator()(const f32x4 (&acc)[2][2][4][2], const Unit& u, int wr, int wc, int fr, int fq) const {
        asm volatile("" : "+v"(fr), "+v"(fq));
        const int pn = u.pn; bf16_t* base; int ld = 1024, colt; int kind;
        if (pn < 4) { base = w.qa; colt = pn * 256; kind = 1; } else if (pn < 8) { base = w.ka; colt = (pn - 4) * 256; kind = 1; }
        else if (pn < 12) { base = w.va; colt = (pn - 8) * 256; kind = 0; } else if (pn < 16) { base = w.qb; colt = (pn - 12) * 256; kind = 0; }
        else if (pn < 20) { base = w.kb; colt = (pn - 16) * 256; kind = 0; } else if (pn < 24) { base = w.vb; colt = (pn - 20) * 256; kind = 0; }
        else if (pn < 32) { base = w.sga; colt = (pn - 24) * 256; kind = 2; ld = DM; } else { base = w.sgb; colt = (pn - 32) * 256; kind = 2; ld = DM; }
        if (u.pm >= 64 && kind == 1) kind = 0;
        const int row0 = u.pm * BM + wr * 64 + fr, col0 = colt + wc * 32 + 8 * fq;
        const bool hi = (fq >> 1) != 0;
        const bool isq = pn < 4, isk = (pn >= 4 && pn < 8); float kmx[2] = {0.f, 0.f};
#pragma unroll
        for (int ai = 0; ai < 2; ++ai)
#pragma unroll
            for (int m = 0; m < 4; ++m) {
                const int t = row0 + ai * HALF + m * 16; bf16_t* rowp = base + (size_t)t * ld + col0;
                f32x4 cs0 = {1.f, 1.f, 1.f, 1.f}, cs1 = cs0, sn0 = {0.f, 0.f, 0.f, 0.f}, sn1 = sn0;
                if (kind == 1) { const int pos = (wc & 1) ? (t & 63) : ((t >> 6) & 255); const int o = pos * 16 + 8 * (fq & 1);
                    cs0 = *(const f32x4*)(rcos + o); cs1 = *(const f32x4*)(rcos + o + 4); sn0 = *(const f32x4*)(rsin + o); sn1 = *(const f32x4*)(rsin + o + 4);
                    if (!hi) { sn0 = -sn0; sn1 = -sn1; } }
#pragma unroll
                for (int bj = 0; bj < 2; ++bj) { f32x4 v0 = acc[ai][bj][m][0], v1 = acc[ai][bj][m][1];
                    if (kind == 1) { f32x4 p0, p1;
#pragma unroll
                        for (int j = 0; j < 4; ++j) { auto r0 = __builtin_amdgcn_permlane32_swap(__float_as_uint(v0[j]), __float_as_uint(v0[j]), false, false); p0[j] = __uint_as_float(hi ? r0[0] : r0[1]);
                            auto r1 = __builtin_amdgcn_permlane32_swap(__float_as_uint(v1[j]), __float_as_uint(v1[j]), false, false); p1[j] = __uint_as_float(hi ? r1[0] : r1[1]); }
                        v0 = v0 * cs0 + p0 * sn0; v1 = v1 * cs1 + p1 * sn1; }
                    if (isq) { v0 = v0 * QC; v1 = v1 * QC; }
                    if (isk) { float ss = (v0[0] * v0[0] + v0[1] * v0[1]) + (v0[2] * v0[2] + v0[3] * v0[3]) + (v1[0] * v1[0] + v1[1] * v1[1]) + (v1[2] * v1[2] + v1[3] * v1[3]);
                        ss += __shfl_xor(ss, 16); ss += __shfl_xor(ss, 32); kmx[bj] = fmaxf(kmx[bj], ss); }
                    if (kind == 2) {
#pragma unroll
                        for (int j = 0; j < 4; ++j) { v0[j] = fmaxf(__builtin_amdgcn_rcpf(1.0f + __expf(-v0[j])), 1e-20f); v1[j] = fmaxf(__builtin_amdgcn_rcpf(1.0f + __expf(-v1[j])), 1e-20f); } }
                    u32x4 o; o.x = cvt_pk_bf16(v0[0], v0[1]); o.y = cvt_pk_bf16(v0[2], v0[3]); o.z = cvt_pk_bf16(v1[0], v1[1]); o.w = cvt_pk_bf16(v1[2], v1[3]);
                    *(u32x4*)(rowp + bj * HALF) = o; }
            }
        if (isk) {
#pragma unroll
            for (int bj = 0; bj < 2; ++bj) { float m = kmx[bj];
                for (int o = 8; o >= 1; o >>= 1) m = fmaxf(m, __shfl_xor(m, o));
                if (fr == 0 && fq == 0) atomicMax(w.kmax + (((pn - 4) * 2 + bj) * 2 + (wc >> 1)) * 2 + (wc & 1), __float_as_uint(m)); } }
    }
};
struct EpiMerge1M {
    static constexpr bool PERM = true; static constexpr int MID_T = 16;
    const bf16_t* sga; const bf16_t* sgb; bf16_t* out;
    __device__ __forceinline__ void mid(f32x4 (&acc)[2][2][4][2], const Unit& u, int wr, int wc, int fr, int fq) const {
        asm volatile("" : "+v"(fr), "+v"(fq));
        const int row0 = u.pm * BM + wr * 64 + fr, col0 = u.pn * BM + wc * 32 + 8 * fq;
#pragma unroll
        for (int ai = 0; ai < 2; ++ai)
#pragma unroll
            for (int mp = 0; mp < 2; ++mp) { uint2 ga[2][2], gb[2][2];
#pragma unroll
                for (int mm = 0; mm < 2; ++mm) { const size_t off = (size_t)(row0 + ai * HALF + (mp * 2 + mm) * 16) * DM + col0;
#pragma unroll
                    for (int bj = 0; bj < 2; ++bj) { ga[mm][bj] = *(const uint2*)((const unsigned char*)sga + off + bj * HALF); gb[mm][bj] = *(const uint2*)((const unsigned char*)sgb + off + bj * HALF); } }
#pragma unroll
                for (int mm = 0; mm < 2; ++mm) { const int m = mp * 2 + mm;
#pragma unroll
                    for (int bj = 0; bj < 2; ++bj) { const unsigned aw[2] = {ga[mm][bj].x, ga[mm][bj].y}, bw[2] = {gb[mm][bj].x, gb[mm][bj].y};
#pragma unroll
                        for (int jj = 0; jj < 2; ++jj) { const auto a0 = __builtin_amdgcn_cvt_pk_f32_fp8((int)aw[jj], false), a1 = __builtin_amdgcn_cvt_pk_f32_fp8((int)aw[jj], true), b0 = __builtin_amdgcn_cvt_pk_f32_fp8((int)bw[jj], false), b1 = __builtin_amdgcn_cvt_pk_f32_fp8((int)bw[jj], true);
                            acc[ai][bj][m][jj][0] *= a0[0] * __builtin_amdgcn_rcpf(b0[0]); acc[ai][bj][m][jj][1] *= a0[1] * __builtin_amdgcn_rcpf(b0[1]); acc[ai][bj][m][jj][2] *= a1[0] * __builtin_amdgcn_rcpf(b1[0]); acc[ai][bj][m][jj][3] *= a1[1] * __builtin_amdgcn_rcpf(b1[1]); } } }
                asm volatile("" ::: "memory"); }
    }
    __device__ __forceinline__ void operator()(const f32x4 (&acc)[2][2][4][2], const Unit& u, int wr, int wc, int fr, int fq) const {
        asm volatile("" : "+v"(fr), "+v"(fq));
        const int row0 = u.pm * BM + wr * 64 + fr, col0 = u.pn * BM + wc * 32 + 8 * fq;
#pragma unroll
        for (int ai = 0; ai < 2; ++ai)
#pragma unroll
            for (int mp = 0; mp < 2; ++mp) { uint2 gb[2][2];
#pragma unroll
              for (int mm = 0; mm < 2; ++mm)
#pragma unroll
                for (int bj = 0; bj < 2; ++bj) gb[mm][bj] = *(const uint2*)((const unsigned char*)sgb + (size_t)(row0 + ai * HALF + (mp * 2 + mm) * 16) * DM + col0 + bj * HALF);
#pragma unroll
              for (int mm = 0; mm < 2; ++mm) { const int m = mp * 2 + mm; const size_t off = (size_t)(row0 + ai * HALF + m * 16) * DM + col0;
#pragma unroll
                for (int bj = 0; bj < 2; ++bj) { const uint2 b = gb[mm][bj]; const unsigned bw[2] = {b.x, b.y};
                    const f32x4 v0 = acc[ai][bj][m][0], v1 = acc[ai][bj][m][1]; float r[8];
#pragma unroll
                    for (int jj = 0; jj < 2; ++jj) { const auto b0 = __builtin_amdgcn_cvt_pk_f32_fp8((int)bw[jj], false), b1 = __builtin_amdgcn_cvt_pk_f32_fp8((int)bw[jj], true); const f32x4& v = jj ? v1 : v0; r[4 * jj] = v[0] * b0[0]; r[4 * jj + 1] = v[1] * b0[1]; r[4 * jj + 2] = v[2] * b1[0]; r[4 * jj + 3] = v[3] * b1[1]; }
                    int p0 = 0, p1 = 0;
                    p0 = __builtin_amdgcn_cvt_pk_fp8_f32(r[0] * 8.0f, r[1] * 8.0f, p0, false); p0 = __builtin_amdgcn_cvt_pk_fp8_f32(r[2] * 8.0f, r[3] * 8.0f, p0, true);
                    p1 = __builtin_amdgcn_cvt_pk_fp8_f32(r[4] * 8.0f, r[5] * 8.0f, p1, false); p1 = __builtin_amdgcn_cvt_pk_fp8_f32(r[6] * 8.0f, r[7] * 8.0f, p1, true);
                    *(uint2*)((unsigned char*)out + off + bj * HALF) = make_uint2((unsigned)p0, (unsigned)p1); } }
                asm volatile("" ::: "memory"); }
    }
};
struct EpiResidB {
    static constexpr bool PERM = true; static constexpr int MID_T = 0;
    const float* x; const float* gt; bf16_t* out;
    __device__ __forceinline__ void operator()(const f32x4 (&acc)[2][2][4][2], const Unit& u, int wr, int wc, int fr, int fq) const {
        asm volatile("" : "+v"(fr), "+v"(fq));
        const int row0 = u.pm * BM + wr * 64 + fr, col0 = u.pn * BM + wc * 32 + 8 * fq;
        f32x4 gv[2][2];
#pragma unroll
        for (int bj = 0; bj < 2; ++bj)
#pragma unroll
            for (int n = 0; n < 2; ++n) gv[bj][n] = *(const f32x4*)(gt + col0 + bj * HALF + n * 4);
#pragma unroll
        for (int ai = 0; ai < 2; ++ai)
#pragma unroll
            for (int mp = 0; mp < 2; ++mp) { f32x4 xv[2][2][2];
#pragma unroll
              for (int mm = 0; mm < 2; ++mm) { const size_t off = (size_t)(row0 + ai * HALF + (mp * 2 + mm) * 16) * DM + col0;
#pragma unroll
                for (int bj = 0; bj < 2; ++bj)
#pragma unroll
                    for (int n = 0; n < 2; ++n) xv[mm][bj][n] = *(const f32x4*)(x + off + bj * HALF + n * 4); }
#pragma unroll
              for (int mm = 0; mm < 2; ++mm) { const int m = mp * 2 + mm; const size_t off = (size_t)(row0 + ai * HALF + m * 16) * DM + col0;
#pragma unroll
                for (int bj = 0; bj < 2; ++bj) { const f32x4 y0 = xv[mm][bj][0] + gv[bj][0] * acc[ai][bj][m][0], y1 = xv[mm][bj][1] + gv[bj][1] * acc[ai][bj][m][1];
                    u32x4 o; o.x = cvt_pk_bf16(y0[0], y0[1]); o.y = cvt_pk_bf16(y0[2], y0[3]); o.z = cvt_pk_bf16(y1[0], y1[1]); o.w = cvt_pk_bf16(y1[2], y1[3]);
                    *(u32x4*)(out + off + bj * HALF) = o; } }
                asm volatile("" ::: "memory"); }
    }
};
struct EpiResidM {
    static constexpr bool PERM = false; static constexpr int MID_T = 0;
    const float* x; const float* gt; float* out;
    __device__ __forceinline__ void operator()(const f32x4 (&acc)[2][2][4][2], const Unit& u, int wr, int wc, int fr, int fq) const {
        asm volatile("" : "+v"(fr), "+v"(fq));
        const int row0 = u.pm * BM + wr * 64 + fr, col0 = u.pn * BM + wc * 32 + 4 * fq;
        f32x4 gv[2][2];
#pragma unroll
        for (int bj = 0; bj < 2; ++bj)
#pragma unroll
            for (int n = 0; n < 2; ++n) gv[bj][n] = *(const f32x4*)(gt + col0 + bj * HALF + n * 16);
#pragma unroll
        for (int ai = 0; ai < 2; ++ai)
#pragma unroll
            for (int mp = 0; mp < 2; ++mp) { f32x4 xv[2][2][2];
#pragma unroll
              for (int mm = 0; mm < 2; ++mm) { const size_t off = (size_t)(row0 + ai * HALF + (mp * 2 + mm) * 16) * DM + col0;
#pragma unroll
                for (int bj = 0; bj < 2; ++bj)
#pragma unroll
                    for (int n = 0; n < 2; ++n) xv[mm][bj][n] = *(const f32x4*)(x + off + bj * HALF + n * 16); }
#pragma unroll
              for (int mm = 0; mm < 2; ++mm) { const int m = mp * 2 + mm; const size_t off = (size_t)(row0 + ai * HALF + m * 16) * DM + col0;
#pragma unroll
                for (int bj = 0; bj < 2; ++bj)
#pragma unroll
                    for (int n = 0; n < 2; ++n) *(f32x4*)(out + off + bj * HALF + n * 16) = xv[mm][bj][n] + gv[bj][n] * acc[ai][bj][m][n]; }
                asm volatile("" ::: "memory"); }
    }
};
struct EpiBf16M {
    static constexpr bool PERM = true; static constexpr int MID_T = 0;
    bf16_t* out; int ld;
    __device__ __forceinline__ void operator()(const f32x4 (&acc)[2][2][4][2], const Unit& u, int wr, int wc, int fr, int fq) const {
        asm volatile("" : "+v"(fr), "+v"(fq));
        const int row0 = u.pm * BM + wr * 64 + fr, col0 = u.pn * BM + wc * 32 + 8 * fq;
#pragma unroll
        for (int ai = 0; ai < 2; ++ai)
#pragma unroll
            for (int m = 0; m < 4; ++m) { bf16_t* rowp = out + (size_t)(row0 + ai * HALF + m * 16) * ld + col0;
#pragma unroll
                for (int bj = 0; bj < 2; ++bj) { const f32x4 v0 = acc[ai][bj][m][0], v1 = acc[ai][bj][m][1];
                    u32x4 o; o.x = cvt_pk_bf16(v0[0], v0[1]); o.y = cvt_pk_bf16(v0[2], v0[3]); o.z = cvt_pk_bf16(v1[0], v1[1]); o.w = cvt_pk_bf16(v1[2], v1[3]);
                    *(u32x4*)(rowp + bj * HALF) = o; } }
    }
};
struct EpiQ {
    static constexpr bool PERM = true; static constexpr int MID_T = 0;
    bf16_t* out; int ld; const unsigned long long* rowss; const unsigned long long* bq; float* rinv;
    __device__ __forceinline__ void operator()(const f32x4 (&acc)[2][2][4][2], const Unit& u, int wr, int wc, int fr, int fq) const {
        asm volatile("" : "+v"(fr), "+v"(fq));
        const int row0 = u.pm * BM + wr * 64 + fr, col0 = u.pn * BM + wc * 32 + 8 * fq;
        f32x4 bv[2][2]; float rs[2][4];
#pragma unroll
        for (int bj = 0; bj < 2; ++bj)
#pragma unroll
            for (int k = 0; k < 8; ++k) bv[bj][k >> 2][k & 3] = (float)(long long)bq[col0 + bj * HALF + k] * 2.3283064365386963e-10f;
#pragma unroll
        for (int ai = 0; ai < 2; ++ai)
#pragma unroll
            for (int m = 0; m < 4; ++m) rs[ai][m] = (float)rowss[row0 + ai * HALF + m * 16] * 2.3283064365386963e-10f;
        asm volatile("" ::: "memory");
#pragma unroll
        for (int ai = 0; ai < 2; ++ai)
#pragma unroll
            for (int m = 0; m < 4; ++m) { const int row = row0 + ai * HALF + m * 16; bf16_t* rowp = out + (size_t)row * ld + col0; const float ri = __builtin_amdgcn_rsqf(rs[ai][m] * (1.0f / DM) + 1e-6f); if (u.pn == 0 && wc == 0 && fq == 0) rinv[row] = ri;
#pragma unroll
                for (int bj = 0; bj < 2; ++bj) { const f32x4 v0 = acc[ai][bj][m][0] * ri + bv[bj][0], v1 = acc[ai][bj][m][1] * ri + bv[bj][1];
                    u32x4 o; o.x = cvt_pk_bf16(v0[0], v0[1]); o.y = cvt_pk_bf16(v0[2], v0[3]); o.z = cvt_pk_bf16(v1[0], v1[1]); o.w = cvt_pk_bf16(v1[2], v1[3]);
                    *(u32x4*)(rowp + bj * HALF) = o; } }
    }
};
template <class Epi, class Sched>
__device__ __forceinline__ void gemm_phase8(PG8_LAS unsigned char* lds, const Gemm g, const Sched& S, const Epi& E) {
    int tid = threadIdx.x; asm volatile("" : "+v"(tid));
    const int wid = __builtin_amdgcn_readfirstlane(tid >> 6), lane = tid & 63, wr = wid >> 2, wc = wid & 3, fr = lane & 15, fq = lane >> 4;
    const int K = g.K / 2, nt = K / BK;
    unsigned voffA[2], voffB[2];
#pragma unroll
    for (int i = 0; i < 2; ++i) { int R, C; stage_rc(tid * 16 + i * 8192, R, C); const int Rb = (R & ~31) + perm32f8(R & 31);
        voffA[i] = (unsigned)(R * K + C) * 2u; voffB[i] = (unsigned)(Rb * K + C) * 2u; }
    const size_t kstep = (size_t)(BK * 2);
    const size_t hstep = (size_t)HALF * K * 2;
    const size_t tstep = 2 * hstep;
    const unsigned ldsw = (unsigned)wid * 1024u;
    const int r32 = lane & 31, hi = lane >> 5; (void)fr; (void)fq;
    const int aoff = lds_byte(wr * 64 + r32, hi * 16), boff = lds_byte(wc * 32 + r32, hi * 16);
#define PG8_SA(b, h) (((b) * 2 + (h)) * HTB)
#define PG8_SB(b, h) ((4 + (b) * 2 + (h)) * HTB)
#define PG8_STAGE(bufoff, gbase, voff) do { _Pragma("unroll") for (int _i = 0; _i < 2; ++_i) \
        __builtin_amdgcn_global_load_lds((const unsigned*)((const char*)(gbase) + (voff)[_i]), (PG8_LAS unsigned*)(lds + (bufoff) + ldsw + _i * 8192), 16, 0, 0); } while (0)
#define PG8_LD32(off) ({ const i32x4 lo_ = *(const PG8_LAS i32x4*)(lds + (off)), hi_ = *(const PG8_LAS i32x4*)(lds + (off) + 16); (i32x8){lo_[0], lo_[1], lo_[2], lo_[3], hi_[0], hi_[1], hi_[2], hi_[3]}; })
#define PG8_LDA(dst, b, h) do { _Pragma("unroll") for (int m = 0; m < 2; ++m) _Pragma("unroll") for (int k = 0; k < 2; ++k) dst[m][k] = PG8_LD32(PG8_SA(b, h) + aoff + m * 4096 + k * 1024); } while (0)
#define PG8_LDB(dst, b, h) do { _Pragma("unroll") for (int k = 0; k < 2; ++k) dst[k] = PG8_LD32(PG8_SB(b, h) + boff + k * 1024); } while (0)
#define PG8_MMA(ai, bj, At, Bt) do { __builtin_amdgcn_s_setprio(1); _Pragma("unroll") for (int m = 0; m < 2; ++m) _Pragma("unroll") for (int k = 0; k < 2; ++k) \
        acc[ai][bj][m] = __builtin_amdgcn_mfma_scale_f32_32x32x64_f8f6f4(Bt[k], At[m][k], acc[ai][bj][m], 0, 0, 0, 0x7f7f7f7f, 0, 0x7f7f7f7f); __builtin_amdgcn_s_setprio(0); } while (0)
#define PG8_WAIT_V(n) asm volatile("s_waitcnt vmcnt(" #n ")" ::: "memory")
#define PG8_WAIT_L(n) asm volatile("s_waitcnt lgkmcnt(" #n ")" ::: "memory")
#define PG8_BAR __builtin_amdgcn_s_barrier()
#define PG8_SCHED __builtin_amdgcn_sched_barrier(0)
#define PG8_KBODY \
            const bool last = (t == nt - 2); \
            const char* a1 = cA + (size_t)(t + 1) * kstep; \
            const char* a2 = last ? nA : cA + (size_t)(t + 2) * kstep; const char* b2 = last ? nB : cB + (size_t)(t + 2) * kstep; \
            const char* a3 = a2 + kstep; const char* b3 = b2 + kstep; \
            PG8_LDB(B0, 0, 0); PG8_SCHED; PG8_LDA(At, 0, 0); PG8_STAGE(PG8_SA(1, 1), a1 + hstep, voffA); \
            PG8_WAIT_L(8); PG8_BAR; PG8_WAIT_L(0); PG8_MMA(0, 0, At, B0); PG8_BAR; PG8_SCHED; \
            PG8_LDB(B1, 0, 1); PG8_STAGE(PG8_SB(0, 0), b2, voffB); \
            PG8_BAR; PG8_WAIT_L(0); PG8_MMA(0, 1, At, B1); PG8_BAR; \
            PG8_LDA(At, 0, 1); PG8_STAGE(PG8_SA(0, 0), a2, voffA); \
            PG8_BAR; PG8_WAIT_L(0); PG8_MMA(1, 0, At, B0); PG8_BAR; PG8_SCHED; \
            PG8_STAGE(PG8_SB(0, 1), b2 + hstep, voffB); \
            PG8_WAIT_V(6); PG8_BAR; PG8_MMA(1, 1, At, B1); PG8_BAR; \
            PG8_LDB(B0, 1, 0); PG8_SCHED; PG8_LDA(At, 1, 0); PG8_STAGE(PG8_SA(0, 1), a2 + hstep, voffA); \
            PG8_WAIT_L(8); PG8_BAR; PG8_WAIT_L(0); PG8_MMA(0, 0, At, B0); PG8_BAR; PG8_SCHED; \
            PG8_LDB(B1, 1, 1); PG8_STAGE(PG8_SB(1, 0), b3, voffB); \
            PG8_BAR; PG8_WAIT_L(0); PG8_MMA(0, 1, At, B1); PG8_BAR; \
            PG8_LDA(At, 1, 1); PG8_STAGE(PG8_SA(1, 0), a3, voffA); \
            PG8_BAR; PG8_WAIT_L(0); PG8_MMA(1, 0, At, B0); PG8_BAR; PG8_SCHED; \
            PG8_STAGE(PG8_SB(1, 1), b3 + hstep, voffB); \
            PG8_WAIT_V(6); PG8_BAR; PG8_MMA(1, 1, At, B1); PG8_BAR;
    Unit cur, nxt; int ui = 0;
    if (!S.next(0, cur)) return;
    f32x16 acc[2][2][2];
#pragma unroll
    for (int a = 0; a < 2; ++a)
#pragma unroll
        for (int b = 0; b < 2; ++b)
#pragma unroll
            for (int m = 0; m < 2; ++m) acc[a][b][m] = f32x16{};
    i32x8 At[2][2], B0[2], B1[2];
    const char* cA = (const char*)g.A + (size_t)cur.pm * tstep; const char* cB = (const char*)g.Bt + (size_t)cur.pn * tstep;
    PG8_STAGE(PG8_SB(0, 0), cB, voffB); PG8_STAGE(PG8_SA(0, 0), cA, voffA); PG8_STAGE(PG8_SB(0, 1), cB + hstep, voffB); PG8_STAGE(PG8_SA(0, 1), cA + hstep, voffA);
    if (wr == 1) PG8_BAR;
    PG8_WAIT_V(4); PG8_BAR;
    PG8_STAGE(PG8_SB(1, 0), cB + kstep, voffB); PG8_STAGE(PG8_SA(1, 0), cA + kstep, voffA); PG8_STAGE(PG8_SB(1, 1), cB + hstep + kstep, voffB);
    PG8_WAIT_V(6); PG8_BAR;
    for (;;) {
        const bool has_next = S.next(ui + 1, nxt);
        const char* nA = has_next ? (const char*)g.A + (size_t)nxt.pm * tstep : cA; const char* nB = has_next ? (const char*)g.Bt + (size_t)nxt.pn * tstep : cB;
        if constexpr (Epi::MID_T > 0) {
            for (int t = 0; t < Epi::MID_T; t += 2) { PG8_KBODY }
            E.mid(acc, cur, wr, wc, r32, hi);
            for (int t = Epi::MID_T; t < nt; t += 2) { PG8_KBODY }
        } else {
            for (int t = 0; t < nt; t += 2) { PG8_KBODY }
        }
        E(acc, cur, wr, wc, r32, hi);
        if (!has_next) break;
#pragma unroll
        for (int a = 0; a < 2; ++a)
#pragma unroll
            for (int b = 0; b < 2; ++b)
#pragma unroll
                for (int m = 0; m < 2; ++m) acc[a][b][m] = f32x16{};
        cur = nxt; cA = nA; cB = nB; ++ui;
    }
    PG8_WAIT_V(0);
    if (wr == 0) PG8_BAR;
    PG8_BAR;
#undef PG8_KBODY
#undef PG8_SA
#undef PG8_SB
#undef PG8_STAGE
#undef PG8_LD32
#undef PG8_LDA
#undef PG8_LDB
#undef PG8_MMA
#undef PG8_WAIT_V
#undef PG8_WAIT_L
#undef PG8_BAR
#undef PG8_SCHED
}


constexpr float WSC = 1.0f / 64.0f;
struct EpiResidB8 {
    static constexpr int MID_T = 0; static constexpr bool PERM = true;
    const float* x; const float* gt; bf16_t* out; float sc; unsigned long long* rowss; unsigned char* out8;
    __device__ __forceinline__ void operator()(const f32x16 (&acc)[2][2][2], const Unit& u, int wr, int wc, int r32, int hi) const {
        { int ln_; asm volatile("v_mbcnt_lo_u32_b32 %0, -1, 0\n\tv_mbcnt_hi_u32_b32 %0, -1, %0" : "=v"(ln_)); r32 = ln_ & 31; hi = ln_ >> 5; }
        const int row0 = u.pm * BM + wr * 64 + r32, col0 = u.pn * BM + wc * 32 + 16 * hi;
        f32x4 gv[2][4]; float ssr[2][2];
#pragma unroll
        for (int bj = 0; bj < 2; ++bj)
#pragma unroll
            for (int n = 0; n < 4; ++n) gv[bj][n] = *(const f32x4*)(gt + col0 + bj * HALF + n * 4) * sc;
#pragma unroll
        for (int ai = 0; ai < 2; ++ai)
#pragma unroll
            for (int m = 0; m < 2; ++m) { const size_t off = (size_t)(row0 + ai * HALF + m * 32) * DM + col0; f32x4 xv[2][4]; float ss = 0.f;
#pragma unroll
                for (int bj = 0; bj < 2; ++bj)
#pragma unroll
                    for (int n = 0; n < 4; ++n) xv[bj][n] = *(const f32x4*)(x + off + bj * HALF + n * 4);
#pragma unroll
                for (int bj = 0; bj < 2; ++bj) { float y[16];
#pragma unroll
                    for (int n = 0; n < 4; ++n)
#pragma unroll
                        for (int k = 0; k < 4; ++k) y[4 * n + k] = xv[bj][n][k] + gv[bj][n][k] * acc[ai][bj][m][4 * n + k];
                    u32x4 o0, o1;
                    o0.x = cvt_pk_bf16(y[0], y[1]); o0.y = cvt_pk_bf16(y[2], y[3]); o0.z = cvt_pk_bf16(y[4], y[5]); o0.w = cvt_pk_bf16(y[6], y[7]);
                    o1.x = cvt_pk_bf16(y[8], y[9]); o1.y = cvt_pk_bf16(y[10], y[11]); o1.z = cvt_pk_bf16(y[12], y[13]); o1.w = cvt_pk_bf16(y[14], y[15]);
                    *(u32x4*)(out + off + bj * HALF) = o0; *(u32x4*)(out + off + bj * HALF + 8) = o1;
                    int pk[4];
#pragma unroll
                    for (int q = 0; q < 4; ++q) { int w_ = 0; w_ = __builtin_amdgcn_cvt_pk_fp8_f32(y[4 * q] * 8.0f, y[4 * q + 1] * 8.0f, w_, false); w_ = __builtin_amdgcn_cvt_pk_fp8_f32(y[4 * q + 2] * 8.0f, y[4 * q + 3] * 8.0f, w_, true); pk[q] = w_; }
                    *(u32x4*)(out8 + off + bj * HALF) = (u32x4){(unsigned)pk[0], (unsigned)pk[1], (unsigned)pk[2], (unsigned)pk[3]};
#pragma unroll
                    for (int k = 0; k < 16; ++k) ss += y[k] * y[k]; }
                { auto rr = __builtin_amdgcn_permlane32_swap(__float_as_uint(ss), __float_as_uint(ss), false, false); ssr[ai][m] = __uint_as_float(rr[0]) + __uint_as_float(rr[1]); }
                asm volatile("" ::: "memory"); }
        if (hi == 0) {
#pragma unroll
            for (int ai = 0; ai < 2; ++ai)
#pragma unroll
                for (int m = 0; m < 2; ++m) atomicAdd(rowss + row0 + ai * HALF + m * 32, (unsigned long long)(ssr[ai][m] * 4294967296.0f)); }
    }
};
struct EpiMerge8 {
    static constexpr int MID_T = 8; static constexpr bool PERM = true;
    const unsigned char* sga; const unsigned char* sgb; unsigned char* out;
    __device__ __forceinline__ void mid(f32x16 (&acc)[2][2][2], const Unit& u, int wr, int wc, int r32, int hi) const {
        { int ln_; asm volatile("v_mbcnt_lo_u32_b32 %0, -1, 0\n\tv_mbcnt_hi_u32_b32 %0, -1, %0" : "=v"(ln_)); r32 = ln_ & 31; hi = ln_ >> 5; }
        const int row0 = u.pm * BM + wr * 64 + r32, col0 = u.pn * BM + wc * 32 + 16 * hi;
#pragma unroll
        for (int ai = 0; ai < 2; ++ai) { u32x4 ga[2][2], gb[2][2];
#pragma unroll
            for (int m = 0; m < 2; ++m)
#pragma unroll
                for (int bj = 0; bj < 2; ++bj) { const size_t off = (size_t)(row0 + ai * HALF + m * 32) * DM + col0 + bj * HALF; ga[m][bj] = *(const u32x4*)(sga + off); gb[m][bj] = *(const u32x4*)(sgb + off); }
#pragma unroll
            for (int m = 0; m < 2; ++m)
#pragma unroll
                for (int bj = 0; bj < 2; ++bj) { const unsigned aw[4] = {ga[m][bj].x, ga[m][bj].y, ga[m][bj].z, ga[m][bj].w}, bw[4] = {gb[m][bj].x, gb[m][bj].y, gb[m][bj].z, gb[m][bj].w};
#pragma unroll
                    for (int q = 0; q < 4; ++q) { const auto a0 = __builtin_amdgcn_cvt_pk_f32_fp8((int)aw[q], false), a1 = __builtin_amdgcn_cvt_pk_f32_fp8((int)aw[q], true), b0 = __builtin_amdgcn_cvt_pk_f32_fp8((int)bw[q], false), b1 = __builtin_amdgcn_cvt_pk_f32_fp8((int)bw[q], true);
                        acc[ai][bj][m][4 * q] *= a0[0] * __builtin_amdgcn_rcpf(b0[0]); acc[ai][bj][m][4 * q + 1] *= a0[1] * __builtin_amdgcn_rcpf(b0[1]); acc[ai][bj][m][4 * q + 2] *= a1[0] * __builtin_amdgcn_rcpf(b1[0]); acc[ai][bj][m][4 * q + 3] *= a1[1] * __builtin_amdgcn_rcpf(b1[1]); } }
            asm volatile("" ::: "memory"); }
    }
    __device__ __forceinline__ void operator()(const f32x16 (&acc)[2][2][2], const Unit& u, int wr, int wc, int r32, int hi) const {
        { int ln_; asm volatile("v_mbcnt_lo_u32_b32 %0, -1, 0\n\tv_mbcnt_hi_u32_b32 %0, -1, %0" : "=v"(ln_)); r32 = ln_ & 31; hi = ln_ >> 5; }
        const int row0 = u.pm * BM + wr * 64 + r32, col0 = u.pn * BM + wc * 32 + 16 * hi;
        u32x4 gb[2][2][2];
#pragma unroll
        for (int ai = 0; ai < 2; ++ai)
#pragma unroll
            for (int m = 0; m < 2; ++m)
#pragma unroll
                for (int bj = 0; bj < 2; ++bj) gb[ai][m][bj] = *(const u32x4*)(sgb + (size_t)(row0 + ai * HALF + m * 32) * DM + col0 + bj * HALF);
        asm volatile("" ::: "memory");
#pragma unroll
        for (int ai = 0; ai < 2; ++ai)
#pragma unroll
            for (int m = 0; m < 2; ++m)
#pragma unroll
                for (int bj = 0; bj < 2; ++bj) { const unsigned bw[4] = {gb[ai][m][bj].x, gb[ai][m][bj].y, gb[ai][m][bj].z, gb[ai][m][bj].w}; int pk[4];
#pragma unroll
                    for (int q = 0; q < 4; ++q) { const auto b0 = __builtin_amdgcn_cvt_pk_f32_fp8((int)bw[q], false), b1 = __builtin_amdgcn_cvt_pk_f32_fp8((int)bw[q], true);
                        int w_ = 0; w_ = __builtin_amdgcn_cvt_pk_fp8_f32(acc[ai][bj][m][4 * q] * b0[0] * (1.0f / 64.0f), acc[ai][bj][m][4 * q + 1] * b0[1] * (1.0f / 64.0f), w_, false);
                        w_ = __builtin_amdgcn_cvt_pk_fp8_f32(acc[ai][bj][m][4 * q + 2] * b1[0] * (1.0f / 64.0f), acc[ai][bj][m][4 * q + 3] * b1[1] * (1.0f / 64.0f), w_, true); pk[q] = w_; }
                    *(u32x4*)(out + (size_t)(row0 + ai * HALF + m * 32) * DM + col0 + bj * HALF) = (u32x4){(unsigned)pk[0], (unsigned)pk[1], (unsigned)pk[2], (unsigned)pk[3]}; }
    }
};
struct EpiInProj8 {
    static constexpr int MID_T = 0; static constexpr bool PERM = true;
    WS w; const float* rcos; const float* rsin;
    static constexpr float QC = 0.125f * 1.4426950408889634f, QCB = 0.08838834764831845f * 1.4426950408889634f;
    __device__ __forceinline__ void operator()(const f32x16 (&acc)[2][2][2], const Unit& u, int wr, int wc, int r32, int hi) const {
        asm volatile("" : "+v"(r32), "+v"(hi));
        const int pn = u.pn; bf16_t* base; int ld = 1024, colt; int kind;
        if (pn < 4) { base = w.qa; colt = pn * 256; kind = 1; } else if (pn < 8) { base = w.ka; colt = (pn - 4) * 256; kind = 1; }
        else if (pn < 12) { base = w.va; colt = (pn - 8) * 256; kind = 0; } else if (pn < 16) { base = w.qb; colt = (pn - 12) * 256; kind = 0; }
        else if (pn < 20) { base = w.kb; colt = (pn - 16) * 256; kind = 0; } else if (pn < 24) { base = w.vb; colt = (pn - 20) * 256; kind = 0; }
        else if (pn < 32) { base = w.sga; colt = (pn - 24) * 256; kind = 2; ld = DM; } else { base = w.sgb; colt = (pn - 32) * 256; kind = 2; ld = DM; }
        if (u.pm >= 64 && kind == 1) kind = 0;
        const bool isb = pn >= 12 && pn < 24; const int pq = isb ? pn - 12 : pn;
        const bool isq = pq < 4, isk = (pq >= 4 && pq < 8), isv = (pq >= 8 && pq < 12); float kmx[2] = {0.f, 0.f};
        const int row0 = u.pm * BM + wr * 64 + r32, col0 = colt + wc * 32 + 16 * hi;
#pragma unroll
        for (int ai = 0; ai < 2; ++ai)
#pragma unroll
            for (int m = 0; m < 2; ++m) {
                const int t = row0 + ai * HALF + m * 32; bf16_t* rowp = base + (size_t)t * ld + col0;
                float cs[16], sn[16];
                if (kind == 1) { const int pos = (wc & 1) ? (t & 63) : ((t >> 6) & 255);
#pragma unroll
                    for (int q = 0; q < 4; ++q) { const f32x4 c4 = *(const f32x4*)(rcos + pos * 16 + q * 4), s4 = *(const f32x4*)(rsin + pos * 16 + q * 4);
#pragma unroll
                        for (int j = 0; j < 4; ++j) { cs[q * 4 + j] = c4[j]; sn[q * 4 + j] = hi ? s4[j] : -s4[j]; } } }
#pragma unroll
                for (int bj = 0; bj < 2; ++bj) { float v[16];
#pragma unroll
                    for (int r = 0; r < 16; ++r) v[r] = acc[ai][bj][m][r] * WSC;
                    if (kind == 1) {
#pragma unroll
                        for (int r = 0; r < 16; ++r) { auto rr = __builtin_amdgcn_permlane32_swap(__float_as_uint(v[r]), __float_as_uint(v[r]), false, false); const float pv = __uint_as_float(hi ? rr[0] : rr[1]); v[r] = v[r] * cs[r] + pv * sn[r]; } }
                    if (isq) {
#pragma unroll
                        for (int r = 0; r < 16; ++r) v[r] *= (isb ? QCB : QC) * 4.0f; }
                    if (isk) { float ss = 0.f;
#pragma unroll
                        for (int r = 0; r < 16; ++r) v[r] *= 0.25f;
#pragma unroll
                        for (int r = 0; r < 16; ++r) ss += v[r] * v[r];
                        { auto rr = __builtin_amdgcn_permlane32_swap(__float_as_uint(ss), __float_as_uint(ss), false, false); ss = __uint_as_float(rr[0]) + __uint_as_float(rr[1]); }
                        kmx[bj] = fmaxf(kmx[bj], ss); }
                    if (kind == 2) {
#pragma unroll
                        for (int r = 0; r < 16; ++r) v[r] = fmaxf(__builtin_amdgcn_rcpf(1.0f + __expf(-v[r])), 0.001953125f);
                        int pk[4] = {0, 0, 0, 0};
#pragma unroll
                        for (int q4 = 0; q4 < 4; ++q4) { pk[q4] = __builtin_amdgcn_cvt_pk_fp8_f32(v[q4 * 4], v[q4 * 4 + 1], pk[q4], false); pk[q4] = __builtin_amdgcn_cvt_pk_fp8_f32(v[q4 * 4 + 2], v[q4 * 4 + 3], pk[q4], true); }
                        *(u32x4*)((unsigned char*)base + (size_t)t * DM + col0 + bj * HALF) = (u32x4){(unsigned)pk[0], (unsigned)pk[1], (unsigned)pk[2], (unsigned)pk[3]};
                        continue; }
                    if (isv) {
                        const int k = t & 63, kk = k & 31, pos = 32 * ((kk >> 2) & 1) + 16 * (k >> 5) + (kk & 3) + 4 * (kk >> 3);
                        unsigned char* vp = (unsigned char*)(isb ? w.vb : w.va) + ((size_t)(((pq - 8) * 2 + bj) * 128 + wc * 32 + 16 * hi)) * TOT + (size_t)(t >> 6) * 64 + pos;
#pragma unroll
                        for (int q4 = 0; q4 < 4; ++q4) { int pk = 0; pk = __builtin_amdgcn_cvt_pk_fp8_f32(v[q4 * 4], v[q4 * 4 + 1], pk, false); pk = __builtin_amdgcn_cvt_pk_fp8_f32(v[q4 * 4 + 2], v[q4 * 4 + 3], pk, true);
                            vp[(size_t)(q4 * 4 + 0) * TOT] = (unsigned char)pk; vp[(size_t)(q4 * 4 + 1) * TOT] = (unsigned char)(pk >> 8); vp[(size_t)(q4 * 4 + 2) * TOT] = (unsigned char)(pk >> 16); vp[(size_t)(q4 * 4 + 3) * TOT] = (unsigned char)(pk >> 24); }
                    } else if (isq || isk) { int pk[4] = {0, 0, 0, 0};
#pragma unroll
                        for (int q4 = 0; q4 < 4; ++q4) { pk[q4] = __builtin_amdgcn_cvt_pk_fp8_f32(v[q4 * 4], v[q4 * 4 + 1], pk[q4], false); pk[q4] = __builtin_amdgcn_cvt_pk_fp8_f32(v[q4 * 4 + 2], v[q4 * 4 + 3], pk[q4], true); }
                        *(u32x4*)((unsigned char*)base + (size_t)t * 1024 + col0 + bj * HALF) = (u32x4){(unsigned)pk[0], (unsigned)pk[1], (unsigned)pk[2], (unsigned)pk[3]};
                    } else {
                    u32x4 o0, o1;
                    o0.x = cvt_pk_bf16(v[0], v[1]); o0.y = cvt_pk_bf16(v[2], v[3]); o0.z = cvt_pk_bf16(v[4], v[5]); o0.w = cvt_pk_bf16(v[6], v[7]);
                    o1.x = cvt_pk_bf16(v[8], v[9]); o1.y = cvt_pk_bf16(v[10], v[11]); o1.z = cvt_pk_bf16(v[12], v[13]); o1.w = cvt_pk_bf16(v[14], v[15]);
                    *(u32x4*)(rowp + bj * HALF) = o0; *(u32x4*)(rowp + bj * HALF + 8) = o1; } }
            }
        if (isk && !isb) {
#pragma unroll
            for (int bj = 0; bj < 2; ++bj) { float mm = kmx[bj];
                for (int o = 16; o >= 1; o >>= 1) mm = fmaxf(mm, __shfl_xor(mm, o));
                if (r32 == 0 && hi == 0) atomicMax(w.kmax + (((pn - 4) * 2 + bj) * 2 + (wc >> 1)) * 2 + (wc & 1), __float_as_uint(mm)); } }
    }
};
}

__device__ __forceinline__ void prep_transpose(int tile, char* lds, const float* __restrict__ W, int ldn, int K, int N, bf16_t* Wt, int ldk, int koff, const float* __restrict__ fg = nullptr, const float* __restrict__ fs = nullptr, const float* __restrict__ sh = nullptr, unsigned long long* bacc = nullptr) {
  float (*T)[129] = (float (*)[129])lds;
  int tid = threadIdx.x; asm volatile("" : "+v"(tid));
  const int ntn = N / 128, tk = tile / ntn, tn = tile % ntn, k0 = tk * 64, n0 = tn * 128;
  __syncthreads();
#pragma unroll
  for (int i = 0; i < 4; ++i) { const int e = tid + i * 512, r = e >> 5, c4 = (e & 31) * 4; const float4 v = *(const float4*)(W + (size_t)(k0 + r) * ldn + n0 + c4);
    T[r][c4] = v.x; T[r][c4 + 1] = v.y; T[r][c4 + 2] = v.z; T[r][c4 + 3] = v.w; }
  __syncthreads();
#pragma unroll
  for (int i = 0; i < 2; ++i) { const int e = tid + i * 512, n = e >> 3, k8 = (e & 7) * 8; pg8::u32x4 o;
    if (fg) {
      float t8[8], bs = 0.f;
#pragma unroll
      for (int j = 0; j < 8; ++j) { const float wv_ = T[k8 + j][n]; bs += wv_ * sh[k0 + k8 + j]; t8[j] = wv_ * fg[k0 + k8 + j] * (1.0f + fs[k0 + k8 + j]); }
      bs += __shfl_xor(bs, 1); bs += __shfl_xor(bs, 2); bs += __shfl_xor(bs, 4);
      if ((e & 7) == 0) atomicAdd(bacc + n0 + n, (unsigned long long)(long long)(bs * 4294967296.0f));
      o.x = pg8::cvt_pk_bf16(t8[0], t8[1]); o.y = pg8::cvt_pk_bf16(t8[2], t8[3]); o.z = pg8::cvt_pk_bf16(t8[4], t8[5]); o.w = pg8::cvt_pk_bf16(t8[6], t8[7]);
    } else {
    o.x = pg8::cvt_pk_bf16(T[k8][n], T[k8 + 1][n]); o.y = pg8::cvt_pk_bf16(T[k8 + 2][n], T[k8 + 3][n]); o.z = pg8::cvt_pk_bf16(T[k8 + 4][n], T[k8 + 5][n]); o.w = pg8::cvt_pk_bf16(T[k8 + 6][n], T[k8 + 7][n]); }
    *(pg8::u32x4*)(Wt + (size_t)(n0 + n) * ldk + koff + k0 + k8) = o; }
}

__device__ __forceinline__ void prep_transpose8(int tile, char* lds, const float* __restrict__ W, int ldn, int K, int N, unsigned char* Wt, int ldk, int koff) {
  float (*T)[129] = (float (*)[129])lds;
  int tid = threadIdx.x; asm volatile("" : "+v"(tid));
  const int ntn = N / 128, tk = tile / ntn, tn = tile % ntn, k0 = tk * 64, n0 = tn * 128;
  __syncthreads();
#pragma unroll
  for (int i = 0; i < 4; ++i) { const int e = tid + i * 512, r = e >> 5, c4 = (e & 31) * 4; const float4 v = *(const float4*)(W + (size_t)(k0 + r) * ldn + n0 + c4);
    T[r][c4] = v.x * 64.0f; T[r][c4 + 1] = v.y * 64.0f; T[r][c4 + 2] = v.z * 64.0f; T[r][c4 + 3] = v.w * 64.0f; }
  __syncthreads();
#pragma unroll
  for (int i = 0; i < 2; ++i) { const int e = tid + i * 512, n = e >> 3, k8 = (e & 7) * 8; int a = 0, b = 0;
    a = __builtin_amdgcn_cvt_pk_fp8_f32(T[k8][n], T[k8 + 1][n], a, false); a = __builtin_amdgcn_cvt_pk_fp8_f32(T[k8 + 2][n], T[k8 + 3][n], a, true);
    b = __builtin_amdgcn_cvt_pk_fp8_f32(T[k8 + 4][n], T[k8 + 5][n], b, false); b = __builtin_amdgcn_cvt_pk_fp8_f32(T[k8 + 6][n], T[k8 + 7][n], b, true);
    *(uint2*)(Wt + (size_t)(n0 + n) * ldk + koff + k0 + k8) = make_uint2((unsigned)a, (unsigned)b); }
}

namespace at {
typedef short bf16x8 __attribute__((ext_vector_type(8)));
typedef short s16x4 __attribute__((ext_vector_type(4)));
typedef float f32x16 __attribute__((ext_vector_type(16)));
typedef unsigned u32x4 __attribute__((ext_vector_type(4)));
constexpr int NW = 8, QBLK = 32, KVBLK = 64, LDQ = 1024, LDK = 1024;
constexpr int SHM_V = 16384, SHM_K = 16384, OFF_K = 2 * SHM_V, OFF_WS = 2 * SHM_V + 2 * SHM_K, OFF_STASH = OFF_WS + NW * 64 * 4, STASH_BYTES = 256 * 128 * 2, OFF_END = OFF_STASH + STASH_BYTES;
constexpr float LOG2E = 1.4426950408889634f;
#define AT_KSWZ(row, colB) ((row) * 256 + ((colB) ^ (((row) & 7) << 4)))
#define AT_SBAR() __builtin_amdgcn_sched_barrier(0)
__device__ __forceinline__ int crow(int r, int hi) { return (r & 3) + 8 * (r >> 2) + 4 * hi; }
__device__ __forceinline__ unsigned cvtpk(float lo, float hi) { unsigned r; asm volatile("v_cvt_pk_bf16_f32 %0, %1, %2" : "=v"(r) : "v"(lo), "v"(hi)); return r; }

template <class Hook>
__device__ __forceinline__ void partialSM(f32x16& p0, f32x16& p1, float& m_reg, float& mn, float& alpha) {
  constexpr float C = Hook::SCALE * LOG2E, THRS = 8.0f / Hook::SCALE;
  float pmax = p0[0];
#pragma unroll
  for (int r = 1; r < 16; ++r) pmax = fmaxf(pmax, p0[r]);
#pragma unroll
  for (int r = 0; r < 16; ++r) pmax = fmaxf(pmax, p1[r]);
  { auto rr = __builtin_amdgcn_permlane32_swap(__float_as_uint(pmax), __float_as_uint(pmax), false, false); pmax = fmaxf(__uint_as_float(rr[0]), __uint_as_float(rr[1])); }
  if (__builtin_expect(__all(pmax - m_reg <= THRS), 1)) { mn = m_reg; alpha = 1.f; }
  else { mn = fmaxf(m_reg, pmax); alpha = __builtin_amdgcn_exp2f((m_reg - mn) * C); m_reg = mn; }
  const float mnC = -mn * C;
#pragma unroll
  for (int r = 0; r < 16; ++r) p0[r] = fmaf(p0[r], C, mnC);
#pragma unroll
  for (int r = 0; r < 16; ++r) p1[r] = fmaf(p1[r], C, mnC);
#pragma unroll
  for (int r = 0; r < 16; ++r) p0[r] = __builtin_amdgcn_exp2f(p0[r]);
}
__device__ __forceinline__ void finishSM(f32x16& p0, f32x16& p1, float alpha, float& l_reg, bf16x8& pa0, bf16x8& pa1, bf16x8& pa2, bf16x8& pa3) {
#pragma unroll
  for (int r = 0; r < 16; ++r) p1[r] = __builtin_amdgcn_exp2f(p1[r]);
  float ps = 0;
#pragma unroll
  for (int r = 0; r < 16; ++r) ps += p0[r];
#pragma unroll
  for (int r = 0; r < 16; ++r) ps += p1[r];
  { auto rr = __builtin_amdgcn_permlane32_swap(__float_as_uint(ps), __float_as_uint(ps), false, false); ps = __uint_as_float(rr[0]) + __uint_as_float(rr[1]); }
  l_reg = l_reg * alpha + ps;
#define AT_PK4(P, BASE, OUT) do { unsigned a0 = cvtpk(P[BASE + 0], P[BASE + 1]), a1 = cvtpk(P[BASE + 2], P[BASE + 3]);   \
    unsigned b0 = cvtpk(P[BASE + 4], P[BASE + 5]), b1 = cvtpk(P[BASE + 6], P[BASE + 7]);                              \
    auto r0 = __builtin_amdgcn_permlane32_swap(a0, b0, false, false); auto r1 = __builtin_amdgcn_permlane32_swap(a1, b1, false, false); \
    u32x4 w = {r0[0], r1[0], r0[1], r1[1]}; OUT = *reinterpret_cast<bf16x8*>(&w); } while (0)
  AT_PK4(p0, 0, pa0); AT_PK4(p0, 8, pa1); AT_PK4(p1, 0, pa2); AT_PK4(p1, 8, pa3);
#undef AT_PK4
}
template <int ND0>
__device__ __forceinline__ void qkt(f32x16& p0, f32x16& p1, const char* Ks, const bf16x8* qr, int r32, int hi, int kcolB) {
#pragma unroll
  for (int d0 = 0; d0 < ND0; ++d0) { const int cb = kcolB + (d0 * 16 + hi * 8) * 2;
    const bf16x8 b0 = *reinterpret_cast<const bf16x8*>(Ks + AT_KSWZ(r32, cb));
    const bf16x8 b1 = *reinterpret_cast<const bf16x8*>(Ks + AT_KSWZ(32 + r32, cb));
    p0 = __builtin_amdgcn_mfma_f32_32x32x16_bf16(b0, qr[d0], p0, 0, 0, 0);
    p1 = __builtin_amdgcn_mfma_f32_32x32x16_bf16(b1, qr[d0], p1, 0, 0, 0); }
}
__device__ __forceinline__ int v_st(int k, int c) { const int kk = (k & ~0xC) | ((k & 4) << 1) | ((k & 8) >> 1); return ((kk >> 3) * 4 + (c >> 5)) * 512 + ((kk & 7) * 32 + (c & 31)) * 2; }
__device__ __forceinline__ int v_rd_base(int lane) { return ((lane & 3) << 3) | (((lane >> 2) & 3) << 6) | (((lane >> 4) & 1) << 5) | (((lane >> 5) & 1) << 8); }
constexpr int v_rd_off(int d0, int ks, int half) { return d0 * 512 + ks * 4096 + half * 2048; }
template <int OFF> __device__ __forceinline__ s16x4 tr_read(int vb) { s16x4 r; asm volatile("ds_read_b64_tr_b16 %0, %1 offset:%2" : "=&v"(r) : "v"(vb), "i"(OFF) : "memory"); return r; }
template <int D0> __device__ __forceinline__ void pv_one(f32x16& od, int vb, bf16x8 pa0, bf16x8 pa1, bf16x8 pa2, bf16x8 pa3) {
  const s16x4 l0 = tr_read<v_rd_off(D0, 0, 0)>(vb), h0 = tr_read<v_rd_off(D0, 0, 1)>(vb), l1 = tr_read<v_rd_off(D0, 1, 0)>(vb), h1 = tr_read<v_rd_off(D0, 1, 1)>(vb);
  const s16x4 l2 = tr_read<v_rd_off(D0, 2, 0)>(vb), h2 = tr_read<v_rd_off(D0, 2, 1)>(vb), l3 = tr_read<v_rd_off(D0, 3, 0)>(vb), h3 = tr_read<v_rd_off(D0, 3, 1)>(vb);
  asm volatile("s_waitcnt lgkmcnt(0)" ::: "memory"); AT_SBAR();
#define AT_PK(L, H) (bf16x8){L[0], L[1], L[2], L[3], H[0], H[1], H[2], H[3]}
  od = __builtin_amdgcn_mfma_f32_32x32x16_bf16(pa0, AT_PK(l0, h0), od, 0, 0, 0);
  od = __builtin_amdgcn_mfma_f32_32x32x16_bf16(pa1, AT_PK(l1, h1), od, 0, 0, 0);
  od = __builtin_amdgcn_mfma_f32_32x32x16_bf16(pa2, AT_PK(l2, h2), od, 0, 0, 0);
  od = __builtin_amdgcn_mfma_f32_32x32x16_bf16(pa3, AT_PK(l3, h3), od, 0, 0, 0);
#undef AT_PK
}
__device__ __forceinline__ void pv_d0(f32x16* o, int vb, bf16x8 pa0, bf16x8 pa1, bf16x8 pa2, bf16x8 pa3) {
  pv_one<0>(o[0], vb, pa0, pa1, pa2, pa3); pv_one<1>(o[1], vb, pa0, pa1, pa2, pa3); pv_one<2>(o[2], vb, pa0, pa1, pa2, pa3); pv_one<3>(o[3], vb, pa0, pa1, pa2, pa3);
}

template <int ND0, class Hook>
__device__ __forceinline__ void attn_pass(const bf16_t* __restrict__ Qb, const bf16_t* __restrict__ Kh, const bf16_t* __restrict__ Vh, int NT, int kcolB, const Hook& H, char* lds, f32x16 (&o)[4], float& l_out) {
  int tid = threadIdx.x; asm volatile("" : "+v"(tid));
  const int wid = __builtin_amdgcn_readfirstlane(tid >> 6), lane = tid & 63, r32 = lane & 31, hi = lane >> 5;
  char* V_lds = lds; char* K_lds = lds + OFF_K;
  float* ws = (float*)(lds + OFF_WS) + wid * 64; float* al_l = ws + 32;
  float m_reg = -1e30f, l_reg = 0; bf16x8 qr[ND0];
#pragma unroll
  for (int d = 0; d < 4; ++d) o[d] = f32x16{};
  const bf16_t* Qw = Qb + (long)(wid * QBLK + r32) * LDQ + hi * 8;
#pragma unroll
  for (int d0 = 0; d0 < ND0; ++d0) qr[d0] = *reinterpret_cast<const bf16x8*>(Qw + d0 * 16);
  const int sr = tid >> 4, sc = (tid & 15) * 8, vst0 = v_st(sr, sc), vst1 = v_st(32 + sr, sc);
  const int vb0 = (int)(uintptr_t)V_lds + v_rd_base(lane);
  struct { bf16x8 vs0, vs1, ks0, ks1; } sr_[2];
#define AT_SLOAD(i, jj) do { const long k0_ = H.krow(jj); sr_[i].vs0 = *(const bf16x8*)(&Vh[(k0_ + sr) * LDK + sc]); sr_[i].vs1 = *(const bf16x8*)(&Vh[(k0_ + 32 + sr) * LDK + sc]); \
    sr_[i].ks0 = *(const bf16x8*)(&Kh[(k0_ + sr) * LDK + sc]); sr_[i].ks1 = *(const bf16x8*)(&Kh[(k0_ + 32 + sr) * LDK + sc]); } while (0)
#define AT_SWRITE(b, i) do { *(bf16x8*)(V_lds + (b) * SHM_V + vst0) = sr_[i].vs0; *(bf16x8*)(V_lds + (b) * SHM_V + vst1) = sr_[i].vs1; const int kc = sc * 2; \
    *(bf16x8*)(K_lds + (b) * SHM_K + AT_KSWZ(sr, kc)) = sr_[i].ks0; *(bf16x8*)(K_lds + (b) * SHM_K + AT_KSWZ(32 + sr, kc)) = sr_[i].ks1; } while (0)
#define AT_SWAIT() asm volatile("s_waitcnt vmcnt(4)" ::: "memory")
#define AT_RESC(a) do { if (__any((a) < 1.f)) { if (hi == 0) al_l[r32] = (a); asm volatile("s_waitcnt lgkmcnt(0)" ::: "memory"); \
    _Pragma("unroll") for (int d = 0; d < 4; ++d) _Pragma("unroll") for (int r = 0; r < 16; ++r) o[d][r] *= al_l[crow(r, hi)]; } } while (0)
  f32x16 pA0, pA1, pB0, pB1; float mnA, mnB, alA, alB; bf16x8 pa0, pa1, pa2, pa3;
  __syncthreads();
  AT_SLOAD(0, 0); asm volatile("s_waitcnt vmcnt(0)" ::: "memory"); AT_SWRITE(0, 0); __syncthreads();
  H.init(pA0, pA1, 0, wid, r32, hi); if (!H.skip(0, wid)) qkt<ND0>(pA0, pA1, K_lds, qr, r32, hi, kcolB); partialSM<Hook>(pA0, pA1, m_reg, mnA, alA);
  AT_SLOAD(1, 1); if (2 < NT) AT_SLOAD(0, 2);
  AT_SWAIT(); AT_SWRITE(1, 1); __syncthreads();
  for (int j = 1; j + 1 < NT; j += 2) {
    AT_SBAR(); H.init(pB0, pB1, j, wid, r32, hi); if (!H.skip(j, wid)) qkt<ND0>(pB0, pB1, K_lds + SHM_K, qr, r32, hi, kcolB);
    finishSM(pA0, pA1, alA, l_reg, pa0, pa1, pa2, pa3); AT_SBAR();
    AT_SLOAD(1, j + 2); AT_SBAR();
    if (!H.skip(j - 1, wid)) pv_d0(o, vb0, pa0, pa1, pa2, pa3); partialSM<Hook>(pB0, pB1, m_reg, mnB, alB);
    __syncthreads(); AT_SWAIT(); AT_SWRITE(0, 0);
    AT_RESC(alB); __syncthreads();
    AT_SBAR(); H.init(pA0, pA1, j + 1, wid, r32, hi); if (!H.skip(j + 1, wid)) qkt<ND0>(pA0, pA1, K_lds, qr, r32, hi, kcolB);
    finishSM(pB0, pB1, alB, l_reg, pa0, pa1, pa2, pa3); AT_SBAR();
    if (j + 3 < NT) AT_SLOAD(0, j + 3); AT_SBAR();
    if (!H.skip(j, wid)) pv_d0(o, vb0 + SHM_V, pa0, pa1, pa2, pa3); partialSM<Hook>(pA0, pA1, m_reg, mnA, alA);
    __syncthreads(); AT_SWAIT(); AT_SWRITE(1, 1);
    AT_RESC(alA); __syncthreads();
  }
  AT_SBAR(); H.init(pB0, pB1, NT - 1, wid, r32, hi); if (!H.skip(NT - 1, wid)) qkt<ND0>(pB0, pB1, K_lds + SHM_K, qr, r32, hi, kcolB);
  finishSM(pA0, pA1, alA, l_reg, pa0, pa1, pa2, pa3); AT_SBAR();
  if (!H.skip(NT - 2, wid)) pv_d0(o, vb0, pa0, pa1, pa2, pa3); partialSM<Hook>(pB0, pB1, m_reg, mnB, alB);
  __syncthreads(); AT_RESC(alB);
  finishSM(pB0, pB1, alB, l_reg, pa0, pa1, pa2, pa3); AT_SBAR();
  if (!H.skip(NT - 1, wid)) pv_d0(o, vb0 + SHM_V, pa0, pa1, pa2, pa3);
  asm volatile("s_waitcnt vmcnt(0)" ::: "memory");
  l_out = l_reg;
#undef AT_SLOAD
#undef AT_SWRITE
#undef AT_SWAIT
#undef AT_RESC
}
__device__ __forceinline__ void row_rcp(float l_reg, char* lds, int wid, int r32, int hi, float (&rli)[16]) {
  float* li_l = (float*)(lds + OFF_WS) + wid * 64;
  if (hi == 0) li_l[r32] = l_reg; asm volatile("s_waitcnt lgkmcnt(0)" ::: "memory");
#pragma unroll
  for (int r = 0; r < 16; ++r) rli[r] = __builtin_amdgcn_rcpf(li_l[crow(r, hi)]);
  asm volatile("s_waitcnt lgkmcnt(0)" ::: "memory");
}

struct HookNA { static constexpr float SCALE = 0.08838834764831845f;
  int r0, rs_lo, nw; const float* bias;
  __device__ __forceinline__ long krow(int j) const { return j < nw ? (long)(rs_lo + j) * 64 : (j < nw + 4 ? (long)SEQ + (j - nw) * 64 : (long)SEQ); }
  __device__ __forceinline__ bool skip(int j, int wid) const {
    if (j >= nw) return j >= nw + 4;
    const int rq = r0 + (wid >> 1), kr = rs_lo + j; int rs = rq - 4; rs = rs < 0 ? 0 : (rs > 248 ? 248 : rs);
    return kr < rs || kr > rs + 7; }
  __device__ __forceinline__ void init(f32x16& p0, f32x16& p1, int j, int wid, int r32, int hi) const {
    const float ninf = -__builtin_inff();
    if (j >= nw) { const float v = (j >= nw + 4) ? ninf : 0.f;
#pragma unroll
      for (int r = 0; r < 16; ++r) { p0[r] = v; p1[r] = v; }
      return; }
    const int rq = r0 + (wid >> 1), c = (wid & 1) * 32 + r32, kr = rs_lo + j;
    int rs = rq - 4; rs = rs < 0 ? 0 : (rs > 248 ? 248 : rs); int cs = c - 8; cs = cs < 0 ? 0 : (cs > 48 ? 48 : cs);
    if (kr < rs || kr > rs + 7) {
#pragma unroll
      for (int r = 0; r < 16; ++r) { p0[r] = ninf; p1[r] = ninf; }
      return; }
    const float* brow = bias + (kr - rq + 7) * 32 + (15 - c) + 4 * hi; const int b0 = 4 * hi - cs;
#pragma unroll
    for (int r = 0; r < 16; ++r) { const int cr = (r & 3) + 8 * (r >> 2);
      const float x0 = brow[cr], x1 = brow[32 + cr];
      p0[r] = ((unsigned)(b0 + cr) < 16u) ? x0 : ninf; p1[r] = ((unsigned)(b0 + 32 + cr) < 16u) ? x1 : ninf; }
  } };
__device__ __forceinline__ void na_item(int h, int rb, const bf16_t* qb, const bf16_t* kb, const bf16_t* vb, const float* __restrict__ rpb, bf16_t* outb, char* lds) {
  int tid = threadIdx.x; asm volatile("" : "+v"(tid));
  const int wid = tid >> 6, lane = tid & 63, r32 = lane & 31, hi = lane >> 5; const int r0 = rb * 4; const long t0 = (long)r0 * 64;
  float* btab = (float*)(lds + OFF_STASH);
  __syncthreads();
  for (int e = tid; e < 15 * 32; e += 512) { const int dr = e >> 5, dc = e & 31; btab[e] = dc < 31 ? rpb[(h * 15 + dr) * 31 + dc] * 11.313708498984761f : 0.f; }
  HookNA H; H.r0 = r0; int lo = r0 - 4; lo = lo < 0 ? 0 : (lo > 248 ? 248 : lo); int hr = r0 + 3 - 4; hr = hr < 0 ? 0 : (hr > 248 ? 248 : hr);
  H.rs_lo = lo; H.nw = hr + 7 - lo + 1; H.bias = btab;
  const int NT = (H.nw + 4 + 1) & ~1;
  f32x16 o[4]; float l; float rli[16];
  attn_pass<8, HookNA>(qb + t0 * LDQ + h * 128, kb + h * 128, vb + h * 128, NT, 0, H, lds, o, l);
  row_rcp(l, lds, wid, r32, hi, rli);
#pragma unroll
  for (int r = 0; r < 16; ++r) { bf16_t* op = outb + (t0 + wid * 32 + crow(r, hi)) * 2048 + h * 128 + r32;
#pragma unroll
    for (int d0 = 0; d0 < 4; ++d0) op[d0 * 32] = f2bf(o[d0][r] * rli[r]); }
}
}

namespace da {
using at::bf16x8; using at::s16x4; using at::f32x16; using at::u32x4; using at::crow; using at::cvtpk; using at::tr_read; using at::v_rd_off; using at::v_rd_base;
constexpr int OFF_Q = 0, OFF_KR = 32768, KSLOT = 8192, OFF_VR = 49152, SLOTV = 8192;
#define DA_LAS __attribute__((address_space(3)))
template <int CTRL> __device__ __forceinline__ float dppm(float v) { return __int_as_float(__builtin_amdgcn_update_dpp(0, __float_as_int(v), CTRL, 0xF, 0xF, true)); }
__device__ __forceinline__ float half_sum32(float x) {
  x += dppm<0xB1>(x); x += dppm<0x4E>(x);
  x += dppm<0x141>(x);
  x += dppm<0x140>(x);
  auto r = __builtin_amdgcn_permlane16_swap(__float_as_uint(x), __float_as_uint(x), false, false);
  return __uint_as_float(r[0]) + __uint_as_float(r[1]);
}
template <int OFF> __device__ __forceinline__ bf16x8 lds_rd128(unsigned addr) { bf16x8 r; asm volatile("ds_read_b128 %0, %1 offset:%2" : "=v"(r) : "v"(addr), "i"(OFF) : "memory"); return r; }
#define DA_WAIT() do { asm volatile("s_waitcnt lgkmcnt(0)" ::: "memory"); AT_SBAR(); } while (0)
typedef int i32x8 __attribute__((ext_vector_type(8)));
template <int OFF> __device__ __forceinline__ void rd32(bf16x8& lo, bf16x8& hi_, unsigned a0, unsigned a1) { lo = lds_rd128<OFF>(a0); hi_ = lds_rd128<OFF>(a1); }
__device__ __forceinline__ f32x16 qk1(const bf16x8& klo, const bf16x8& khi, const bf16x8& qlo, const bf16x8& qhi) {
  const u32x4 a = *reinterpret_cast<const u32x4*>(&klo), b = *reinterpret_cast<const u32x4*>(&khi), c = *reinterpret_cast<const u32x4*>(&qlo), d = *reinterpret_cast<const u32x4*>(&qhi);
  const i32x8 A = {(int)a[0], (int)a[1], (int)a[2], (int)a[3], (int)b[0], (int)b[1], (int)b[2], (int)b[3]}, B = {(int)c[0], (int)c[1], (int)c[2], (int)c[3], (int)d[0], (int)d[1], (int)d[2], (int)d[3]};
  return __builtin_amdgcn_mfma_scale_f32_32x32x64_f8f6f4(A, B, f32x16{}, 0, 0, 0, 0x7f7f7f7f, 0, 0x7f7f7f7f);
}
template <bool SHIFT>
__device__ __forceinline__ void sm_fin(f32x16& s, float nb, u32x4& pk) {
#pragma unroll
  for (int r = 0; r < 16; ++r) s[r] = __builtin_amdgcn_exp2f(SHIFT ? s[r] + nb : s[r]);
#pragma unroll
  for (int q = 0; q < 4; ++q) { int w = 0; w = __builtin_amdgcn_cvt_pk_bf8_f32(s[4 * q], s[4 * q + 1], w, false); w = __builtin_amdgcn_cvt_pk_bf8_f32(s[4 * q + 2], s[4 * q + 3], w, true); pk[q] = (unsigned)w; }
}
template <bool SHIFT>
__device__ __forceinline__ void tile_sm(const unsigned (&kc)[4], const unsigned (&qb)[4], float nb1, float nb2, u32x4 (&p1)[2], u32x4 (&p2)[2]) {
  bf16x8 ql, qh, kl, kh; f32x16 s0, s1;
  rd32<0>(ql, qh, qb[0], qb[1]); rd32<0>(kl, kh, kc[0], kc[1]);
  DA_WAIT(); s0 = qk1(kl, kh, ql, qh); AT_SBAR();
  rd32<4096>(kl, kh, kc[0], kc[1]);
  DA_WAIT(); s1 = qk1(kl, kh, ql, qh); AT_SBAR();
  rd32<0>(ql, qh, qb[2], qb[3]); rd32<0>(kl, kh, kc[2], kc[3]); AT_SBAR();
  sm_fin<SHIFT>(s0, nb1, p1[0]);
  DA_WAIT(); s0 = qk1(kl, kh, ql, qh); AT_SBAR();
  rd32<4096>(kl, kh, kc[2], kc[3]); AT_SBAR();
  sm_fin<SHIFT>(s1, nb1, p1[1]);
  DA_WAIT(); s1 = qk1(kl, kh, ql, qh); AT_SBAR();
  sm_fin<SHIFT>(s0, nb2, p2[0]);
  AT_SBAR();
  sm_fin<SHIFT>(s1, nb2, p2[1]);
  AT_SBAR();
}
typedef float lsum4 __attribute__((ext_vector_type(4)));
__device__ __forceinline__ void tile_pv(unsigned v0, unsigned v1, const u32x4 (&p1)[2], const u32x4 (&p2)[2], f32x16 (&o1)[4], f32x16 (&o2)[4], lsum4& L1, lsum4& L2, int pat) {
  const i32x8 A1 = {(int)p1[0][0], (int)p1[0][1], (int)p1[0][2], (int)p1[0][3], (int)p1[1][0], (int)p1[1][1], (int)p1[1][2], (int)p1[1][3]};
  const i32x8 A2 = {(int)p2[0][0], (int)p2[0][1], (int)p2[0][2], (int)p2[0][3], (int)p2[1][0], (int)p2[1][1], (int)p2[1][2], (int)p2[1][3]};
  bf16x8 al, ah, bl, bh;
#define DA_PV(D0, L, H) do { const u32x4 x_ = *reinterpret_cast<const u32x4*>(&L), y_ = *reinterpret_cast<const u32x4*>(&H); \
    const i32x8 B_ = {(int)x_[0], (int)x_[1], (int)x_[2], (int)x_[3], (int)y_[0], (int)y_[1], (int)y_[2], (int)y_[3]}; \
    o1[D0] = __builtin_amdgcn_mfma_scale_f32_32x32x64_f8f6f4(A1, B_, o1[D0], 1, 0, 0, 0x7f7f7f7f, 0, 0x7f7f7f7f); \
    o2[D0] = __builtin_amdgcn_mfma_scale_f32_32x32x64_f8f6f4(A2, B_, o2[D0], 1, 0, 0, 0x7f7f7f7f, 0, 0x7f7f7f7f); } while (0)
  rd32<0>(al, ah, v0, v1);
  DA_WAIT(); rd32<2048>(bl, bh, v0, v1); AT_SBAR(); DA_PV(0, al, ah); AT_SBAR();
  DA_WAIT(); rd32<4096>(al, ah, v0, v1); AT_SBAR(); DA_PV(1, bl, bh); AT_SBAR();
  DA_WAIT(); rd32<6144>(bl, bh, v0, v1); AT_SBAR(); DA_PV(2, al, ah); AT_SBAR();
  DA_WAIT(); DA_PV(3, bl, bh);
  { const i32x8 PAT = {pat, pat, pat, pat, pat, pat, pat, pat};
    L1 = __builtin_amdgcn_mfma_scale_f32_16x16x128_f8f6f4(A1, PAT, L1, 1, 0, 0, 0x7f7f7f7f, 0, 0x7f7f7f7f);
    L2 = __builtin_amdgcn_mfma_scale_f32_16x16x128_f8f6f4(A2, PAT, L2, 1, 0, 0, 0x7f7f7f7f, 0, 0x7f7f7f7f); }
  AT_SBAR();
#undef DA_PV
}
__device__ __forceinline__ void diff_attn_item(int h, int qb, const bf16_t* qa, const bf16_t* ka, const bf16_t* va, const float* __restrict__ subln, float lam, const unsigned* kmax, bf16_t* outa, char* lds) {
  int tid = threadIdx.x; asm volatile("" : "+v"(tid));
  const int wid = __builtin_amdgcn_readfirstlane(tid >> 6), lane = tid & 63, r32 = lane & 31, hi = lane >> 5; const long t0 = (long)qb * 256;
  constexpr int NT = TOT / 64;
  unsigned soffk, soffv;
  { const int row = 8 * wid + (lane >> 3), c = (lane & 7) ^ ((row >> 1) & 7); soffk = (unsigned)(row * 1024 + (c << 4)); }
  { const int R = 16 * wid + (lane >> 2), c = (lane & 3) ^ ((R >> 2) & 3); soffv = (unsigned)(R * TOT + (c << 4)); }
  const char* kg = (const char*)ka + h * 128; const char* vg = (const char*)va + (size_t)h * 128 * TOT;
  const __amdgpu_buffer_rsrc_t rk = __builtin_amdgcn_make_buffer_rsrc((void*)kg, 0, TOT * 1024, 0x00020000), rv = __builtin_amdgcn_make_buffer_rsrc((void*)vg, 0, 128 * TOT, 0x00020000);
#define DA_STAGE(j) do { DA_LAS void* dk_ = (DA_LAS void*)(lds + OFF_KR + ((j) & 1) * KSLOT + wid * 1024); DA_LAS void* dv_ = (DA_LAS void*)(lds + OFF_VR + ((j) % 3) * SLOTV + wid * 1024); \
    __builtin_amdgcn_raw_ptr_buffer_load_lds(rk, dk_, 16, soffk, (j) * (64 * 1024), 0, 0); __builtin_amdgcn_raw_ptr_buffer_load_lds(rv, dv_, 16, soffv, (j) * 64, 0, 0); } while (0)
  __syncthreads();
  DA_STAGE(0);
#pragma unroll
  for (int i = 0; i < 4; ++i) { const int e = tid + i * 512, row = e >> 3, c = e & 7; const bf16x8 v = *reinterpret_cast<const bf16x8*>((const char*)qa + (t0 + row) * 1024 + h * 128 + c * 16);
    *reinterpret_cast<bf16x8*>(lds + OFF_Q + row * 128 + ((c ^ ((row >> 1) & 7)) << 4)) = v; }
  asm volatile("s_waitcnt vmcnt(0) lgkmcnt(0)" ::: "memory"); __builtin_amdgcn_s_barrier(); asm volatile("" ::: "memory");
  float nb1, nb2;
  const unsigned ldsb = (unsigned)(uintptr_t)lds;
  unsigned kb[4], qbs[4];
  { const int qrow = wid * 32 + r32, sw = (r32 >> 1) & 7;
#pragma unroll
    for (int i = 0; i < 2; ++i) { const unsigned c0 = (unsigned)(((4 * i + 2 * hi) ^ sw) << 4); kb[2 * i] = ldsb + OFF_KR + r32 * 128 + c0; kb[2 * i + 1] = kb[2 * i] ^ 16u; qbs[2 * i] = ldsb + OFF_Q + qrow * 128 + c0; qbs[2 * i + 1] = qbs[2 * i] ^ 16u; } }
  { float sq[2];
#pragma unroll
    for (int i = 0; i < 2; ++i) { float s = 0.f;
#pragma unroll
      for (int p = 0; p < 2; ++p) { const u32x4 w = *(const DA_LAS u32x4*)(uintptr_t)(qbs[2 * i + p]);
#pragma unroll
        for (int d = 0; d < 4; ++d) { const auto f0 = __builtin_amdgcn_cvt_pk_f32_fp8((int)w[d], false), f1 = __builtin_amdgcn_cvt_pk_f32_fp8((int)w[d], true); s += f0[0] * f0[0] + f0[1] * f0[1] + f1[0] * f1[0] + f1[1] * f1[1]; } }
      auto rr = __builtin_amdgcn_permlane32_swap(__float_as_uint(s), __float_as_uint(s), false, false); sq[i] = __uint_as_float(rr[0]) + __uint_as_float(rr[1]); }
    const float k1 = __uint_as_float(kmax[(h * 2 + 0) * 2]) + __uint_as_float(kmax[(h * 2 + 0) * 2 + 1]), k2 = __uint_as_float(kmax[(h * 2 + 1) * 2]) + __uint_as_float(kmax[(h * 2 + 1) * 2 + 1]);
    nb1 = -1.1f * sqrtf(sq[0] * k1); nb2 = -1.1f * sqrtf(sq[1] * k2); }
  f32x16 o1[4] = {}, o2[4] = {}; lsum4 L1 = {}, L2 = {};
  const int pat = (((lane >> 4) ^ lane) & 1) ? 0 : 0x38383838;
  const unsigned vb0 = ldsb + OFF_VR + r32 * 64 + (((2 * hi) ^ ((r32 >> 2) & 3)) << 4), vb1 = vb0 ^ 16u;
  u32x4 pa1[2], pa2[2];
#define DA_LOOP(SHIFT) do { \
    if (wid < 4) { \
      for (int j = 0; j < NT; ++j) { if (j + 1 < NT) DA_STAGE(j + 1); \
        __builtin_amdgcn_s_setprio(1); tile_sm<SHIFT>(kb, qbs, nb1, nb2, pa1, pa2); __builtin_amdgcn_s_setprio(0); tile_pv(vb0 + (j % 3) * SLOTV, vb1 + (j % 3) * SLOTV, pa1, pa2, o1, o2, L1, L2, pat); \
        _Pragma("unroll") for (int d0 = 0; d0 < 4; ++d0) kb[d0] ^= KSLOT;     \
        asm volatile("s_waitcnt vmcnt(0)" ::: "memory"); __builtin_amdgcn_s_barrier(); asm volatile("" ::: "memory"); } \
    } else { \
      for (int j = 0; j < NT; ++j) { if (j + 1 < NT) DA_STAGE(j + 1); \
        if (j > 0) tile_pv(vb0 + ((j - 1) % 3) * SLOTV, vb1 + ((j - 1) % 3) * SLOTV, pa1, pa2, o1, o2, L1, L2, pat); \
        __builtin_amdgcn_s_setprio(1); tile_sm<SHIFT>(kb, qbs, nb1, nb2, pa1, pa2); __builtin_amdgcn_s_setprio(0); \
        _Pragma("unroll") for (int d0 = 0; d0 < 4; ++d0) kb[d0] ^= KSLOT; \
        asm volatile("s_waitcnt vmcnt(0)" ::: "memory"); __builtin_amdgcn_s_barrier(); asm volatile("" ::: "memory"); } \
      tile_pv(vb0 + ((NT - 1) % 3) * SLOTV, vb1 + ((NT - 1) % 3) * SLOTV, pa1, pa2, o1, o2, L1, L2, pat); \
    } } while (0)
  if (__all(nb1 > -100.f && nb2 > -100.f)) DA_LOOP(false); else DA_LOOP(true);
  __builtin_amdgcn_s_setprio(0);
#undef DA_LOOP
#undef DA_STAGE
  int tid2 = threadIdx.x; asm volatile("" : "+v"(tid2));
  const int wid2 = tid2 >> 6, r32b = tid2 & 31, hib = (tid2 >> 5) & 1;
  float g[4];
#pragma unroll
  for (int d0 = 0; d0 < 4; ++d0) g[d0] = subln[d0 * 32 + r32b];
  float L1f[16], L2f[16];
#pragma unroll
  for (int a = 0; a < 4; ++a) { const int src_ = ((a >> 1) + 16 * (2 * (a & 1) + hib)) * 4;
#pragma unroll
    for (int b = 0; b < 4; ++b) { L1f[4 * a + b] = __int_as_float(__builtin_amdgcn_ds_bpermute(src_, __float_as_int(L1[b]))); L2f[4 * a + b] = __int_as_float(__builtin_amdgcn_ds_bpermute(src_, __float_as_int(L2[b]))); } }
#pragma unroll
  for (int r = 0; r < 16; ++r) { const float a1 = 1.0f / L1f[r], a2 = lam / L2f[r]; float v[4]; float ss = 0.f;
#pragma unroll
    for (int d0 = 0; d0 < 4; ++d0) { v[d0] = o1[d0][r] * a1 - o2[d0][r] * a2; ss += v[d0] * v[d0]; }
    ss = half_sum32(ss);
    const float rinv = rsqrtf(ss * (1.0f / 128.0f) + 1e-6f) * 0.8f;
    unsigned char* op = (unsigned char*)outa + (t0 + wid2 * 32 + crow(r, hib)) * 2048 + h * 128 + r32b;
#pragma unroll
    for (int d0 = 0; d0 < 4; ++d0) { const float y_ = v[d0] * rinv * g[d0] * 8.0f; op[d0 * 32] = (unsigned char)(__builtin_amdgcn_cvt_pk_fp8_f32(y_, y_, 0, false) & 0xff); } }
}
__device__ __forceinline__ void na_item8(int h, int rb, const bf16_t* qb8, const bf16_t* kb8, const bf16_t* vt8b, const float* __restrict__ rpb, bf16_t* outb, char* lds) {
  int tid = threadIdx.x; asm volatile("" : "+v"(tid));
  const int wid = __builtin_amdgcn_readfirstlane(tid >> 6), lane = tid & 63, r32 = lane & 31, hi = lane >> 5; const int r0 = rb * 4; const long t0 = (long)r0 * 64;
  int lo = r0 - 4; lo = lo < 0 ? 0 : (lo > 248 ? 248 : lo); int hr = r0 + 3 - 4; hr = hr < 0 ? 0 : (hr > 248 ? 248 : hr);
  const int nw = hr + 7 - lo + 1, NT = nw + 4;
  constexpr int OFF_BT = OFF_VR + 3 * SLOTV;
  float* btab = (float*)(lds + OFF_BT);
  unsigned soffk, soffv;
  { const int row = 8 * wid + (lane >> 3), c = (lane & 7) ^ ((row >> 1) & 7); soffk = (unsigned)(row * 1024 + (c << 4)); }
  { const int R = 16 * wid + (lane >> 2), c = (lane & 3) ^ ((R >> 2) & 3); soffv = (unsigned)(R * TOT + (c << 4)); }
  const char* kg = (const char*)kb8 + h * 128; const char* vg = (const char*)vt8b + (size_t)h * 128 * TOT;
  const __amdgpu_buffer_rsrc_t rk = __builtin_amdgcn_make_buffer_rsrc((void*)kg, 0, TOT * 1024, 0x00020000), rv = __builtin_amdgcn_make_buffer_rsrc((void*)vg, 0, 128 * TOT, 0x00020000);
#define NA_KROW(j) ((j) < nw ? (lo + (j)) * 64 : SEQ + ((j) - nw) * 64)
#define NA_STAGE(j) do { const int kr_ = NA_KROW(j); DA_LAS void* dk_ = (DA_LAS void*)(lds + OFF_KR + ((j) & 1) * KSLOT + wid * 1024); DA_LAS void* dv_ = (DA_LAS void*)(lds + OFF_VR + ((j) % 3) * SLOTV + wid * 1024); \
    __builtin_amdgcn_raw_ptr_buffer_load_lds(rk, dk_, 16, soffk, kr_ * 1024, 0, 0); __builtin_amdgcn_raw_ptr_buffer_load_lds(rv, dv_, 16, soffv, kr_, 0, 0); } while (0)
  __syncthreads();
  NA_STAGE(0);
  for (int e = tid; e < 16 * 32; e += 512) { const int dr = e >> 5, dc = e & 31; btab[e] = (dr < 15 && dc < 31) ? rpb[(h * 15 + dr) * 31 + dc] * 1.4426950408889634f - 6.0f : 0.f; }
#pragma unroll
  for (int i = 0; i < 4; ++i) { const int e = tid + i * 512, row = e >> 3, c = e & 7; const bf16x8 v = *reinterpret_cast<const bf16x8*>((const char*)qb8 + (t0 + row) * 1024 + h * 128 + c * 16);
    *reinterpret_cast<bf16x8*>(lds + OFF_Q + row * 128 + ((c ^ ((row >> 1) & 7)) << 4)) = v; }
  asm volatile("s_waitcnt vmcnt(0) lgkmcnt(0)" ::: "memory"); __builtin_amdgcn_s_barrier(); asm volatile("" ::: "memory");
  const unsigned ldsb = (unsigned)(uintptr_t)lds;
  unsigned kb[4]; bf16x8 q1l, q1h, q2l, q2h;
  { const int qrow = wid * 32 + r32, sw = (r32 >> 1) & 7; unsigned qa_[4];
#pragma unroll
    for (int i = 0; i < 2; ++i) { const unsigned c0 = (unsigned)(((4 * i + 2 * hi) ^ sw) << 4); kb[2 * i] = ldsb + OFF_KR + r32 * 128 + c0; kb[2 * i + 1] = kb[2 * i] ^ 16u; qa_[2 * i] = ldsb + OFF_Q + qrow * 128 + c0; qa_[2 * i + 1] = qa_[2 * i] ^ 16u; }
    rd32<0>(q1l, q1h, qa_[0], qa_[1]); rd32<0>(q2l, q2h, qa_[2], qa_[3]); DA_WAIT(); }
  f32x16 o[4] = {}; lsum4 L = {};
  const int pat = (((lane >> 4) ^ lane) & 1) ? 0 : 0x38383838;
  const unsigned vb0 = ldsb + OFF_VR + r32 * 64 + (((2 * hi) ^ ((r32 >> 2) & 3)) << 4), vb1 = vb0 ^ 16u;
  const int rq = r0 + (wid >> 1), cq = (wid & 1) * 32 + r32; int rs = rq - 4; rs = rs < 0 ? 0 : (rs > 248 ? 248 : rs); int cs = cq - 8; cs = cs < 0 ? 0 : (cs > 48 ? 48 : cs);
  unsigned wmask = 0;
#pragma unroll
  for (int k = 0; k < 32; ++k) { const int cr = (k & 3) + 8 * ((k & 15) >> 2) + 32 * (k >> 4); wmask |= ((unsigned)(4 * hi - cs + cr) < 16u) ? (1u << k) : 0u; }
  const DA_LAS float* blane = (const DA_LAS float*)(uintptr_t)(ldsb + OFF_BT) + (15 - cq) + 4 * hi;
  u32x4 pk[2]; bool pvalid = false;
#define NA_SM(j) do { const int kr = lo + (j); const bool win = (j) < nw; pvalid = !(win && (kr < rs || kr > rs + 7));        \
    if (pvalid) { const DA_LAS float* brow = blane + (kr - rq + 7) * 32; unsigned wm_ = wmask; asm volatile("" : "+v"(wm_));        \
      _Pragma("unroll") for (int blk = 0; blk < 2; ++blk) { f32x16 s; bf16x8 kl, kh, ml, mh; \
        if (blk == 0) { rd32<0>(kl, kh, kb[0], kb[1]); rd32<0>(ml, mh, kb[2], kb[3]); } else { rd32<4096>(kl, kh, kb[0], kb[1]); rd32<4096>(ml, mh, kb[2], kb[3]); } \
        if (win) { _Pragma("unroll") for (int r = 0; r < 16; ++r) { const int cr = (r & 3) + 8 * (r >> 2); const int t_ = __builtin_amdgcn_sbfe((int)wm_, 16 * blk + r, 1);        \
            s[r] = __uint_as_float(((unsigned)t_ & __float_as_uint(brow[32 * blk + cr])) | (~(unsigned)t_ & 0xff800000u)); } } \
        else { _Pragma("unroll") for (int r = 0; r < 16; ++r) s[r] = -6.0f; } \
        DA_WAIT(); \
        { const u32x4 a = *reinterpret_cast<const u32x4*>(&kl), b = *reinterpret_cast<const u32x4*>(&kh), c = *reinterpret_cast<const u32x4*>(&q1l), d = *reinterpret_cast<const u32x4*>(&q1h); \
          const i32x8 A = {(int)a[0], (int)a[1], (int)a[2], (int)a[3], (int)b[0], (int)b[1], (int)b[2], (int)b[3]}, B = {(int)c[0], (int)c[1], (int)c[2], (int)c[3], (int)d[0], (int)d[1], (int)d[2], (int)d[3]}; \
          s = __builtin_amdgcn_mfma_scale_f32_32x32x64_f8f6f4(A, B, s, 0, 0, 0, 0x7f7f7f7f, 0, 0x7f7f7f7f); } \
        { const u32x4 a = *reinterpret_cast<const u32x4*>(&ml), b = *reinterpret_cast<const u32x4*>(&mh), c = *reinterpret_cast<const u32x4*>(&q2l), d = *reinterpret_cast<const u32x4*>(&q2h); \
          const i32x8 A = {(int)a[0], (int)a[1], (int)a[2], (int)a[3], (int)b[0], (int)b[1], (int)b[2], (int)b[3]}, B = {(int)c[0], (int)c[1], (int)c[2], (int)c[3], (int)d[0], (int)d[1], (int)d[2], (int)d[3]}; \
          s = __builtin_amdgcn_mfma_scale_f32_32x32x64_f8f6f4(A, B, s, 0, 0, 0, 0x7f7f7f7f, 0, 0x7f7f7f7f); } \
        sm_fin<false>(s, 0.f, pk[blk]); AT_SBAR(); } } } while (0)
#define NA_PVT(j) do { if (pvalid) { const unsigned v0 = vb0 + ((j) % 3) * SLOTV, v1 = vb1 + ((j) % 3) * SLOTV; \
      const i32x8 A1 = {(int)pk[0][0], (int)pk[0][1], (int)pk[0][2], (int)pk[0][3], (int)pk[1][0], (int)pk[1][1], (int)pk[1][2], (int)pk[1][3]}; \
      bf16x8 al, ah, bl, bh; \
      rd32<0>(al, ah, v0, v1); \
      DA_WAIT(); rd32<2048>(bl, bh, v0, v1); AT_SBAR(); NA_PV(0, al, ah); AT_SBAR(); \
      DA_WAIT(); rd32<4096>(al, ah, v0, v1); AT_SBAR(); NA_PV(1, bl, bh); AT_SBAR(); \
      DA_WAIT(); rd32<6144>(bl, bh, v0, v1); AT_SBAR(); NA_PV(2, al, ah); AT_SBAR(); \
      DA_WAIT(); NA_PV(3, bl, bh); \
      { int o_ = pat; asm volatile("" : "+v"(o_)); const i32x8 PAT = {o_, o_, o_, o_, o_, o_, o_, o_}; \
        L = __builtin_amdgcn_mfma_scale_f32_16x16x128_f8f6f4(A1, PAT, L, 1, 0, 0, 0x7f7f7f7f, 0, 0x7f7f7f7f); } \
      AT_SBAR(); } } while (0)
#define NA_PV(D0, LL, HH) do { const u32x4 x_ = *reinterpret_cast<const u32x4*>(&LL), y_ = *reinterpret_cast<const u32x4*>(&HH); \
      const i32x8 B_ = {(int)x_[0], (int)x_[1], (int)x_[2], (int)x_[3], (int)y_[0], (int)y_[1], (int)y_[2], (int)y_[3]}; \
      o[D0] = __builtin_amdgcn_mfma_scale_f32_32x32x64_f8f6f4(A1, B_, o[D0], 1, 0, 0, 0x7f7f7f7f, 0, 0x7f7f7f7f); } while (0)
  if (wid < 4) {
#pragma nounroll
    for (int j = 0; j < NT; ++j) { if (j + 1 < NT) NA_STAGE(j + 1);
      __builtin_amdgcn_s_setprio(1); NA_SM(j); __builtin_amdgcn_s_setprio(0); NA_PVT(j);
#pragma unroll
      for (int d0 = 0; d0 < 4; ++d0) kb[d0] ^= KSLOT;
      asm volatile("s_waitcnt vmcnt(0)" ::: "memory"); __builtin_amdgcn_s_barrier(); asm volatile("" ::: "memory"); }
  } else {
#pragma nounroll
    for (int j = 0; j < NT; ++j) { if (j + 1 < NT) NA_STAGE(j + 1);
      if (j > 0) NA_PVT(j - 1);
      __builtin_amdgcn_s_setprio(1); NA_SM(j); __builtin_amdgcn_s_setprio(0);
#pragma unroll
      for (int d0 = 0; d0 < 4; ++d0) kb[d0] ^= KSLOT;
      asm volatile("s_waitcnt vmcnt(0)" ::: "memory"); __builtin_amdgcn_s_barrier(); asm volatile("" ::: "memory"); }
    NA_PVT(NT - 1);
  }
#undef NA_SM
#undef NA_PVT
#undef NA_PV
#undef NA_STAGE
#undef NA_KROW
  int tid2 = threadIdx.x; asm volatile("" : "+v"(tid2));
  const int wid2 = tid2 >> 6, r32b = tid2 & 31, hib = (tid2 >> 5) & 1;
  float Lf[16];
#pragma unroll
  for (int a = 0; a < 4; ++a) { const int src_ = ((a >> 1) + 16 * (2 * (a & 1) + hib)) * 4;
#pragma unroll
    for (int b = 0; b < 4; ++b) Lf[4 * a + b] = __int_as_float(__builtin_amdgcn_ds_bpermute(src_, __float_as_int(L[b]))); }
#pragma unroll
  for (int r = 0; r < 16; ++r) { const float il = 8.0f / Lf[r]; unsigned char* op = (unsigned char*)outb + (t0 + wid2 * 32 + crow(r, hib)) * 2048 + h * 128 + r32b;
#pragma unroll
    for (int d0 = 0; d0 < 4; ++d0) { const float y_ = o[d0][r] * il; op[d0 * 32] = (unsigned char)(__builtin_amdgcn_cvt_pk_fp8_f32(y_, y_, 0, false) & 0xff); } }
}
}

namespace pe {
typedef short bf16x8 __attribute__((ext_vector_type(8)));
typedef float f32x16 __attribute__((ext_vector_type(16)));
typedef unsigned u32x4 __attribute__((ext_vector_type(4)));
typedef float f32x2 __attribute__((ext_vector_type(2)));
__device__ __forceinline__ float gelu_tanh_fast(float x) { const float u = 0.7978845608028654f * (x + 0.044715f * x * x * x); const float e = __builtin_amdgcn_exp2f(u * 2.8853900817779268f); return x * (1.0f - __builtin_amdgcn_rcpf(e + 1.0f)); }
}

namespace p6 {
typedef float v32f __attribute__((ext_vector_type(32)));
typedef unsigned v6u __attribute__((ext_vector_type(6)));
typedef unsigned u32x4 __attribute__((ext_vector_type(4)));
__device__ __forceinline__ unsigned enc_fp6(float x) {
  const float a = fabsf(x); unsigned c;
  if (a < 2.0f) c = (unsigned)__float2int_rn(a * 8.0f);
  else if (a < 4.0f) c = 16u + (unsigned)__float2int_rn((a - 2.0f) * 4.0f);
  else c = 24u + (unsigned)__float2int_rn((a - 4.0f) * 2.0f);
  c = c > 31u ? 31u : c;
  return c | (x < 0.f ? 32u : 0u);
}
__device__ __forceinline__ unsigned enc_fp4(float x) {
  const float a = fabsf(x); unsigned c;
  if (a < 2.0f) c = (unsigned)__float2int_rn(a * 2.0f);
  else if (a < 4.0f) c = 4u + (unsigned)__float2int_rn(a - 2.0f);
  else c = 6u + (unsigned)__float2int_rn((a - 4.0f) * 0.5f);
  c = c > 7u ? 7u : c;
  return c | (x < 0.f ? 8u : 0u);
}
__device__ __forceinline__ void quant_fin4(const float (&v)[32], unsigned char* dst, float* scale, int lane) {
  float mx = 0.f;
#pragma unroll
  for (int j = 0; j < 32; ++j) mx = fmaxf(mx, fabsf(v[j]));
  for (int o = 32; o >= 1; o >>= 1) mx = fmaxf(mx, __shfl_xor(mx, o));
  mx = fmaxf(mx, 1e-30f); const float inv = 6.0f / mx;
  unsigned w[4] = {0u, 0u, 0u, 0u};
#pragma unroll
  for (int d = 0; d < 4; ++d) {
    w[d] = __builtin_amdgcn_cvt_scalef32_pk_fp4_f32(w[d], v[8 * d] * inv, v[8 * d + 1] * inv, 1.0f, 0); w[d] = __builtin_amdgcn_cvt_scalef32_pk_fp4_f32(w[d], v[8 * d + 2] * inv, v[8 * d + 3] * inv, 1.0f, 1);
    w[d] = __builtin_amdgcn_cvt_scalef32_pk_fp4_f32(w[d], v[8 * d + 4] * inv, v[8 * d + 5] * inv, 1.0f, 2); w[d] = __builtin_amdgcn_cvt_scalef32_pk_fp4_f32(w[d], v[8 * d + 6] * inv, v[8 * d + 7] * inv, 1.0f, 3); }
  *(u32x4*)(dst + lane * 16) = (u32x4){w[0], w[1], w[2], w[3]};
  if (lane == 0) *scale = mx * (1.0f / 6.0f);
}
__device__ __forceinline__ void quant_fin4b(const float (&v)[32], unsigned char* dst, unsigned char* sdst, int lane) {
  float mx = 0.f;
#pragma unroll
  for (int j = 0; j < 32; ++j) mx = fmaxf(mx, fabsf(v[j]));
  const int s8 = __builtin_amdgcn_cvt_pk_fp8_f32(mx * (512.0f / 6.0f), 0.f, 0, false) & 0xff;
  const float dec = __builtin_amdgcn_cvt_pk_f32_fp8(s8, false)[0] * (1.0f / 512.0f);
  const float inv = dec > 0.f ? 1.0f / dec : 0.f;
  unsigned w[4] = {0u, 0u, 0u, 0u};
#pragma unroll
  for (int d = 0; d < 4; ++d) {
    w[d] = __builtin_amdgcn_cvt_scalef32_pk_fp4_f32(w[d], v[8 * d] * inv, v[8 * d + 1] * inv, 1.0f, 0); w[d] = __builtin_amdgcn_cvt_scalef32_pk_fp4_f32(w[d], v[8 * d + 2] * inv, v[8 * d + 3] * inv, 1.0f, 1);
    w[d] = __builtin_amdgcn_cvt_scalef32_pk_fp4_f32(w[d], v[8 * d + 4] * inv, v[8 * d + 5] * inv, 1.0f, 2); w[d] = __builtin_amdgcn_cvt_scalef32_pk_fp4_f32(w[d], v[8 * d + 6] * inv, v[8 * d + 7] * inv, 1.0f, 3); }
  *(u32x4*)(dst + lane * 16) = (u32x4){w[0], w[1], w[2], w[3]};
  sdst[lane] = (unsigned char)s8;
}
__device__ __forceinline__ void quant_load_nat(const float* __restrict__ src, float (&v)[32], int lane) {
#pragma unroll
  for (int q = 0; q < 8; ++q) { const float4 t = *(const float4*)(src + lane * 32 + q * 4); v[q * 4] = t.x; v[q * 4 + 1] = t.y; v[q * 4 + 2] = t.z; v[q * 4 + 3] = t.w; }
}
__device__ __forceinline__ void quant_load(const float* __restrict__ src, float (&v)[32], int lane) {
#pragma unroll
  for (int c = 0; c < 2; ++c)
#pragma unroll
    for (int q = 0; q < 4; ++q) { const float4 t = *(const float4*)(src + c * 1024 + lane * 16 + q * 4); v[c * 16 + q * 4] = t.x; v[c * 16 + q * 4 + 1] = t.y; v[c * 16 + q * 4 + 2] = t.z; v[c * 16 + q * 4 + 3] = t.w; }
}
__device__ __forceinline__ void quant_fin(const float (&v)[32], unsigned char* dst, float* scale, int lane) {
  float mx = 0.f;
#pragma unroll
  for (int j = 0; j < 32; ++j) mx = fmaxf(mx, fabsf(v[j]));
  for (int o = 32; o >= 1; o >>= 1) mx = fmaxf(mx, __shfl_xor(mx, o));
  mx = fmaxf(mx, 1e-30f); const float inv = 7.5f / mx;
  unsigned w[6] = {0u, 0u, 0u, 0u, 0u, 0u};
#pragma unroll
  for (int j = 0; j < 32; ++j) { const unsigned code = enc_fp6(v[j] * inv); const int bit = 6 * j, d = bit >> 5, s = bit & 31;
    w[d] |= code << s; if (s > 26) w[d + 1] |= code >> (32 - s); }
  *(u32x4*)(dst + lane * 16) = (u32x4){w[0], w[1], w[2], w[3]}; *(uint2*)(dst + 1024 + lane * 8) = make_uint2(w[4], w[5]);
  if (lane == 0) *scale = mx * (1.0f / 7.5f);
}
template <int CTRL> __device__ __forceinline__ float dpp_mov(float v) { return __int_as_float(__builtin_amdgcn_update_dpp(0, __float_as_int(v), CTRL, 0xF, 0xF, true)); }
__device__ __forceinline__ float reduce16(const float (&p)[16], int lane) {
  float q[8], w[4], y[2];
#pragma unroll
  for (int i = 0; i < 8; ++i) { auto r = __builtin_amdgcn_permlane32_swap(__float_as_uint(p[2 * i]), __float_as_uint(p[2 * i + 1]), false, false); q[i] = __uint_as_float(r[0]) + __uint_as_float(r[1]); }
#pragma unroll
  for (int i = 0; i < 4; ++i) { auto r = __builtin_amdgcn_permlane16_swap(__float_as_uint(q[2 * i]), __float_as_uint(q[2 * i + 1]), false, false); w[i] = __uint_as_float(r[0]) + __uint_as_float(r[1]); }
  const bool b3 = (lane & 8) != 0, b2 = (lane & 4) != 0;
#pragma unroll
  for (int i = 0; i < 2; ++i) { const float t = b3 ? w[2 * i + 1] : w[2 * i], u = b3 ? w[2 * i] : w[2 * i + 1]; y[i] = t + dpp_mov<0x128>(u); }
  const float t = b2 ? y[1] : y[0], u = b2 ? y[0] : y[1];
  float z = t + dpp_mov<0x141>(u);
  z += dpp_mov<0xB1>(z); z += dpp_mov<0x4E>(z);
  return z;
}
typedef float f32x2 __attribute__((ext_vector_type(2)));
typedef int i32x8 __attribute__((ext_vector_type(8)));
typedef float f32x4v __attribute__((ext_vector_type(4)));
__device__ __forceinline__ float wsum64(float x) { x = da::half_sum32(x); auto r = __builtin_amdgcn_permlane32_swap(__float_as_uint(x), __float_as_uint(x), false, false); return __uint_as_float(r[0]) + __uint_as_float(r[1]); }
__device__ __forceinline__ void expert_tokens(int t0, int tstride, int lane, char* ldsw, float* xio, const bf16_t* __restrict__ h2g, const float* __restrict__ mod, const int* __restrict__ pidx, const float* __restrict__ pgate,
                                              const unsigned char* __restrict__ U6, const float* __restrict__ uscale, const unsigned char* __restrict__ V6, const float* __restrict__ fg_) {
  if (t0 >= SEQ) return;
  const int kg = lane >> 4;
  u32x4 A[8], B[8]; unsigned sA[8], sB[8];
  int id0 = pidx[(size_t)t0 * 128 + lane], id1 = pidx[(size_t)t0 * 128 + 64 + lane];
#define P6_ID(k) ({ const int k_ = (k); const int a_ = __builtin_amdgcn_readlane(id0, k_ & 63), b_ = __builtin_amdgcn_readlane(id1, k_ & 63); (k_ & 64) ? b_ : a_; })
#define P6_LOADU(BUF, IDROW, HALF) do { const unsigned char* rp_ = U6 + (size_t)(IDROW) * 1024 + kg * 16 + (HALF) * 512; _Pragma("unroll") for (int r = 0; r < 8; ++r) BUF[r] = *(const u32x4*)(rp_ + r * 64); } while (0)
#define P6_LOADV(BUF, SB, KBASE) do { _Pragma("unroll") for (int r = 0; r < 8; ++r) { const int id_ = P6_ID((KBASE) + r); const unsigned char* vp_ = V6 + (size_t)id_ * 1088; BUF[r] = *(const u32x4*)(vp_ + lane * 16); SB[r] = vp_[1024 + lane]; } } while (0)
#define P6_COMPU(BUF, HALF) do { _Pragma("unroll") for (int r = 0; r < 8; ++r) { const char* bp_ = ldsw + ((HALF) * 8 + r) * 128 + kg * 16; const u32x4 b0_ = *(const u32x4*)bp_, b1_ = *(const u32x4*)(bp_ + 64);        \
      const i32x8 a8_ = {(int)BUF[r].x, (int)BUF[r].y, (int)BUF[r].z, (int)BUF[r].w, 0, 0, 0, 0}, b8_ = {(int)b0_.x, (int)b0_.y, (int)b0_.z, (int)b0_.w, (int)b1_.x, (int)b1_.y, (int)b1_.z, (int)b1_.w}; \
      acc = __builtin_amdgcn_mfma_scale_f32_16x16x128_f8f6f4(a8_, b8_, acc, 4, 0, 0, 0x7f7f7f7f, 0, 0x7f7f7f7f); } } while (0)
#define P6_COMPV(BUF, SB, HALF) do { _Pragma("unroll") for (int r = 0; r < 8; ++r) { const int ee = (HALF) * 8 + r; const float ae = __int_as_float(__builtin_amdgcn_readlane(__float_as_int(a[ee & 3]), (ee >> 2) * 16)); \
      asm volatile("" : "+v"(BUF[r].x) : "v"(outp[15]));        \
      const float cs = ae * __builtin_amdgcn_cvt_pk_f32_fp8((int)SB[r], false)[0]; const f32x2 cc = {cs, cs}; \
      _Pragma("unroll") for (int d = 0; d < 4; ++d) { const unsigned wv_ = BUF[r][d]; \
        const f32x2 f0 = __builtin_amdgcn_cvt_scalef32_pk_f32_fp4(wv_, 1.0f, 0), f1 = __builtin_amdgcn_cvt_scalef32_pk_f32_fp4(wv_, 1.0f, 1), f2 = __builtin_amdgcn_cvt_scalef32_pk_f32_fp4(wv_, 1.0f, 2), f3 = __builtin_amdgcn_cvt_scalef32_pk_f32_fp4(wv_, 1.0f, 3); \
        outp[4 * d] = __builtin_elementwise_fma(f0, cc, outp[4 * d]); outp[4 * d + 1] = __builtin_elementwise_fma(f1, cc, outp[4 * d + 1]); outp[4 * d + 2] = __builtin_elementwise_fma(f2, cc, outp[4 * d + 2]); outp[4 * d + 3] = __builtin_elementwise_fma(f3, cc, outp[4 * d + 3]); } } } while (0)
  int idrow = __shfl(id0, lane & 15);
  P6_LOADU(A, idrow, 0);
  for (int t = t0; t < SEQ; t += tstride) {
    int lt = lane; asm volatile("" : "+v"(lt));
    int z; asm volatile("s_mov_b32 %0, 0" : "=s"(z));
    const float* fg = fg_ + z; const float* gt2 = mod + 5 * DM + z;
    const int tn = t + tstride < SEQ ? t + tstride : t;
    const int nid0 = pidx[(size_t)tn * 128 + lane], nid1 = pidx[(size_t)tn * 128 + 64 + lane];
#pragma unroll
    for (int c = 0; c < 2; ++c) { const u32x4 ha = *(const u32x4*)(h2g + (size_t)t * DM + c * 1024 + lt * 16), hb = *(const u32x4*)(h2g + (size_t)t * DM + c * 1024 + lt * 16 + 8); const unsigned hw[8] = {ha.x, ha.y, ha.z, ha.w, hb.x, hb.y, hb.z, hb.w}; unsigned wq[4];
#pragma unroll
      for (int q = 0; q < 4; ++q) { const float f0 = __uint_as_float(hw[2 * q] << 16) * 8.0f, f1 = __uint_as_float(hw[2 * q] & 0xffff0000u) * 8.0f, f2 = __uint_as_float(hw[2 * q + 1] << 16) * 8.0f, f3 = __uint_as_float(hw[2 * q + 1] & 0xffff0000u) * 8.0f;
        int pk = 0; pk = __builtin_amdgcn_cvt_pk_fp8_f32(f0, f1, pk, false); pk = __builtin_amdgcn_cvt_pk_fp8_f32(f2, f3, pk, true); wq[q] = (unsigned)pk; }
      *(u32x4*)(ldsw + c * 1024 + lt * 16) = (u32x4){wq[0], wq[1], wq[2], wq[3]}; }
    f32x2 outp[16];
#pragma unroll
    for (int j = 0; j < 16; ++j) outp[j] = f32x2{0.f, 0.f};
    const int* ip = pidx + (size_t)t * 128; const float* gp = pgate + (size_t)t * 128;
    float4 gnx = *(const float4*)(gp + 4 * kg); float4 usn; { const int4 i4 = *(const int4*)(ip + 4 * kg); usn.x = uscale[i4.x]; usn.y = uscale[i4.y]; usn.z = uscale[i4.z]; usn.w = uscale[i4.w]; }
#pragma nounroll
    for (int h = 0; h < 8; ++h) {
      f32x4v acc = {0.f, 0.f, 0.f, 0.f};
      P6_LOADU(B, idrow, 1);
      P6_COMPU(A, 0);
      P6_LOADV(A, sA, h * 16);
      P6_COMPU(B, 1);
      float a[4];
      a[0] = gnx.x * pe::gelu_tanh_fast(acc[0] * usn.x * 0.125f) * (1.0f / 512.0f); a[1] = gnx.y * pe::gelu_tanh_fast(acc[1] * usn.y * 0.125f) * (1.0f / 512.0f);
      a[2] = gnx.z * pe::gelu_tanh_fast(acc[2] * usn.z * 0.125f) * (1.0f / 512.0f); a[3] = gnx.w * pe::gelu_tanh_fast(acc[3] * usn.w * 0.125f) * (1.0f / 512.0f);
      { const int hn = h < 7 ? h + 1 : 7; gnx = *(const float4*)(gp + hn * 16 + 4 * kg); const int4 i4 = *(const int4*)(ip + hn * 16 + 4 * kg); usn.x = uscale[i4.x]; usn.y = uscale[i4.y]; usn.z = uscale[i4.z]; usn.w = uscale[i4.w]; }
      P6_LOADV(B, sB, h * 16 + 8);
      P6_COMPV(A, sA, 0);
      { const int srcv = h < 7 ? (((h + 1) & 4) ? id1 : id0) : nid0; idrow = __shfl(srcv, (h < 7 ? ((h + 1) & 3) * 16 : 0) + (lane & 15)); }
      P6_LOADU(A, idrow, 0);
      P6_COMPV(B, sB, 1);
    }
    id0 = nid0; id1 = nid1;
    float xn[32]; float s2 = 0.f;
#pragma unroll
    for (int c = 0; c < 2; ++c)
#pragma unroll
      for (int q = 0; q < 4; ++q) { const float4 v = *(const float4*)(xio + (size_t)t * DM + c * 1024 + lt * 16 + q * 4); xn[c * 16 + q * 4] = v.x; xn[c * 16 + q * 4 + 1] = v.y; xn[c * 16 + q * 4 + 2] = v.z; xn[c * 16 + q * 4 + 3] = v.w; }
#pragma unroll
    for (int c = 0; c < 2; ++c)
#pragma unroll
      for (int j = 0; j < 16; ++j) { const int col = c * 1024 + lt * 16 + j; const float o_ = (j & 1) ? outp[c * 8 + (j >> 1)].y : outp[c * 8 + (j >> 1)].x; const float y = xn[c * 16 + j] + gt2[col] * o_; xn[c * 16 + j] = y; s2 += y * y; }
    s2 = wsum64(s2); const float r2 = rsqrtf(s2 * (1.0f / DM) + 1e-6f);
#pragma unroll
    for (int c = 0; c < 2; ++c)
#pragma unroll
      for (int q = 0; q < 4; ++q) { const int col = c * 1024 + lt * 16 + q * 4; float4 o; o.x = xn[c * 16 + q * 4] * r2 * fg[col]; o.y = xn[c * 16 + q * 4 + 1] * r2 * fg[col + 1]; o.z = xn[c * 16 + q * 4 + 2] * r2 * fg[col + 2]; o.w = xn[c * 16 + q * 4 + 3] * r2 * fg[col + 3];
        *(float4*)(xio + (size_t)t * DM + col) = o; }
  }
#undef P6_ID
#undef P6_LOADU
#undef P6_LOADV
#undef P6_COMPU
#undef P6_COMPV
}
__device__ __forceinline__ void expert_u_slice(int s, int w0, int wstride, int lane, char* ldsw, const unsigned char* __restrict__ h2f8, const int* __restrict__ pidx, const float* __restrict__ pgate,
                                               const unsigned char* __restrict__ U6, const float* __restrict__ uscale, float* __restrict__ act, const float* __restrict__ rowss) {
  if (w0 >= SEQ) return;
  const int n_ = lane & 15, kgb = lane >> 4;
  const int hoff = 32 * n_ + 512 * (kgb >> 1) + 16 * (kgb & 1);
  const bool dg = (kgb == (n_ >> 2)); const int dr = n_ & 3;
  const float mk0 = (dg && dr == 0) ? 1.f : 0.f, mk1 = (dg && dr == 1) ? 1.f : 0.f, mk2 = (dg && dr == 2) ? 1.f : 0.f, mk3 = (dg && dr == 3) ? 1.f : 0.f;
  const int eL = ((lane >> 2) & 1) * 8 + ((lane >> 3) & 1) * 4 + ((lane >> 4) & 1) * 2 + (lane >> 5);
  const unsigned dummy = (255u << 16) | (unsigned)(s * 2048);
#define P6_FILT(CID0, CID1, LST, NOUT) do { const bool in0_ = ((CID0) >> 11) == s, in1_ = ((CID1) >> 11) == s; const unsigned long long m0_ = __ballot(in0_), m1_ = __ballot(in1_); \
    const int n0_ = __popcll(m0_); NOUT = n0_ + __popcll(m1_); (LST)[lane] = dummy; (LST)[64 + lane] = dummy; \
    const int r0_ = __builtin_amdgcn_mbcnt_hi((unsigned)(m0_ >> 32), __builtin_amdgcn_mbcnt_lo((unsigned)m0_, 0)), r1_ = n0_ + __builtin_amdgcn_mbcnt_hi((unsigned)(m1_ >> 32), __builtin_amdgcn_mbcnt_lo((unsigned)m1_, 0)); \
    if (in0_) (LST)[r0_] = ((unsigned)lane << 16) | (unsigned)(CID0); if (in1_) (LST)[r1_] = ((unsigned)(64 + lane) << 16) | (unsigned)(CID1); } while (0)
#define P6_LOADB(BUF, LST, BI) do { const u32x4 ea_ = *(const DA_LAS u32x4*)((LST) + 8 * (BI)), eb_ = *(const DA_LAS u32x4*)((LST) + 8 * (BI) + 4); const unsigned er_[8] = {ea_.x, ea_.y, ea_.z, ea_.w, eb_.x, eb_.y, eb_.z, eb_.w}; \
    _Pragma("unroll") for (int j = 0; j < 8; ++j) { const unsigned id_ = (unsigned)__builtin_amdgcn_readfirstlane((int)er_[j]) & 0xffffu; BUF[j] = *(const u32x4*)(U6 + (size_t)id_ * 1024 + lane * 16); } } while (0)
  const int ntok = (SEQ - w0 + wstride - 1) / wstride;
  DA_LAS unsigned* listC = (DA_LAS unsigned*)(uintptr_t)(unsigned)(uintptr_t)ldsw; DA_LAS unsigned* listN = listC + 128;
  int t = w0, nC, nN;
  { const int i0 = pidx[(size_t)t * 128 + lane], i1 = pidx[(size_t)t * 128 + 64 + lane]; P6_FILT(i0, i1, listC, nC); }
  u32x4 hc0 = *(const u32x4*)(h2f8 + (size_t)t * DM + hoff), hc1 = *(const u32x4*)(h2f8 + (size_t)t * DM + hoff + 1024); float rsc = rowss[t];
  int tn = ntok > 1 ? t + wstride : t;
  int id0 = pidx[(size_t)tn * 128 + lane], id1 = pidx[(size_t)tn * 128 + 64 + lane];
  u32x4 h0 = *(const u32x4*)(h2f8 + (size_t)tn * DM + hoff), h1 = *(const u32x4*)(h2f8 + (size_t)tn * DM + hoff + 1024); float rsx = rowss[tn];
  u32x4 A[8], B[8];
  P6_LOADB(A, listC, 0);
  for (int it = 0; it < ntok; ++it) {
    P6_FILT(id0, id1, listN, nN);
    const u32x4 hn0 = h0, hn1 = h1; const float rsn = rsx;
    const int tnn = it + 2 < ntok ? tn + wstride : tn;
    id0 = pidx[(size_t)tnn * 128 + lane]; id1 = pidx[(size_t)tnn * 128 + 64 + lane];
    h0 = *(const u32x4*)(h2f8 + (size_t)tnn * DM + hoff); h1 = *(const u32x4*)(h2f8 + (size_t)tnn * DM + hoff + 1024); rsx = rowss[tnn];
    const i32x8 b8 = {(int)hc0.x, (int)hc0.y, (int)hc0.z, (int)hc0.w, (int)hc1.x, (int)hc1.y, (int)hc1.z, (int)hc1.w};
    const int NB = (nC + 7) >> 3;
    const float* gp = pgate + (size_t)t * 128;
    if (NB == 0) P6_LOADB(A, listN, 0);
#pragma nounroll
    for (int b = 0; b < NB; ++b) {
      const unsigned ej = listC[8 * b + (eL & 7)];
      const float gt = gp[(ej >> 16) & 127u]; const float2 uc_ = *(const float2*)(uscale + 2 * (ej & 0xffffu)); const float us = uc_.x, ce = uc_.y;
      asm volatile("" ::: "memory");
      if (b + 1 < NB) P6_LOADB(B, listC, b + 1); else P6_LOADB(B, listN, 0);
      asm volatile("" ::: "memory");
      float part[16];
#pragma unroll
      for (int j = 0; j < 8; ++j) { const i32x8 a8 = {(int)A[j].x, (int)A[j].y, (int)A[j].z, (int)A[j].w, 0, 0, 0, 0};
        const f32x4v d = __builtin_amdgcn_mfma_scale_f32_16x16x128_f8f6f4(a8, b8, f32x4v{0.f, 0.f, 0.f, 0.f}, 4, 0, 0, 0x7f7f7f7f, 0, 0x7f7f7f7f);
        part[j] = d[0] * mk0 + d[1] * mk1 + d[2] * mk2 + d[3] * mk3; part[8 + j] = 0.f; }
      const float tot = reduce16(part, lane);
      const unsigned kk = ej >> 16;
      float rs_ = rsc; asm volatile("" : "+v"(rs_));
      if (eL < 8 && (lane & 3) == 0 && kk < 128u) act[(size_t)t * 128 + kk] = gt * pe::gelu_tanh_fast(tot * us * 0.125f * rs_ + ce) * (1.0f / 512.0f);
#pragma unroll
      for (int j = 0; j < 8; ++j) A[j] = B[j];
    }
    { DA_LAS unsigned* x_ = listC; listC = listN; listN = x_; } nC = nN; hc0 = hn0; hc1 = hn1; rsc = rsn; t = tn; tn = tnn;
  }
#undef P6_FILT
#undef P6_LOADB
}
__device__ __forceinline__ void expert_v_tokens(int t0, int tstride, int lane, float* xio, const bf16_t* __restrict__ xb, const float* __restrict__ mod, const int* __restrict__ pidx, const float* __restrict__ act,
                                                const unsigned char* __restrict__ V6, const float* __restrict__ fg_) {
  if (t0 >= SEQ) return;
  u32x4 A[8], B[8]; unsigned sA[8], sB[8];
  int id0 = pidx[(size_t)t0 * 128 + lane], id1 = pidx[(size_t)t0 * 128 + 64 + lane];
#define P6_ID(k) ({ const int k_ = (k); const int a_ = __builtin_amdgcn_readlane(id0, k_ & 63), b_ = __builtin_amdgcn_readlane(id1, k_ & 63); (k_ & 64) ? b_ : a_; })
#define P6_AC(k) ({ const int k_ = (k); const int a_ = __builtin_amdgcn_readlane(__float_as_int(ac0), k_ & 63), b_ = __builtin_amdgcn_readlane(__float_as_int(ac1), k_ & 63); __int_as_float((k_ & 64) ? b_ : a_); })
#define P6_LOADV(BUF, SB, IDEXPR) do { _Pragma("unroll") for (int r = 0; r < 8; ++r) { const int id_ = (IDEXPR); const unsigned char* vp_ = V6 + (size_t)id_ * 1024; BUF[r] = *(const u32x4*)(vp_ + lane * 16); SB[r] = V6[(size_t)16384 * 1024 + (size_t)id_ * 64 + lane]; } } while (0)
#define P6_COMPV(BUF, SB, KBASE) do { _Pragma("unroll") for (int r = 0; r < 8; ++r) { const float ae = P6_AC((KBASE) + r); \
      asm volatile("" : "+v"(BUF[r].x) : "v"(outp[15]));        \
      const float cs = ae * __builtin_amdgcn_cvt_pk_f32_fp8((int)SB[r], false)[0]; const f32x2 cc = {cs, cs}; \
      _Pragma("unroll") for (int d = 0; d < 4; ++d) { const unsigned wv_ = BUF[r][d]; \
        const f32x2 f0 = __builtin_amdgcn_cvt_scalef32_pk_f32_fp4(wv_, 1.0f, 0), f1 = __builtin_amdgcn_cvt_scalef32_pk_f32_fp4(wv_, 1.0f, 1), f2 = __builtin_amdgcn_cvt_scalef32_pk_f32_fp4(wv_, 1.0f, 2), f3 = __builtin_amdgcn_cvt_scalef32_pk_f32_fp4(wv_, 1.0f, 3); \
        outp[4 * d] = __builtin_elementwise_fma(f0, cc, outp[4 * d]); outp[4 * d + 1] = __builtin_elementwise_fma(f1, cc, outp[4 * d + 1]); outp[4 * d + 2] = __builtin_elementwise_fma(f2, cc, outp[4 * d + 2]); outp[4 * d + 3] = __builtin_elementwise_fma(f3, cc, outp[4 * d + 3]); } } } while (0)
  float gtv[32], fgv[32];
#pragma unroll
  for (int c = 0; c < 2; ++c)
#pragma unroll
    for (int j = 0; j < 16; ++j) { gtv[c * 16 + j] = mod[5 * DM + c * 1024 + lane * 16 + j]; fgv[c * 16 + j] = fg_[c * 1024 + lane * 16 + j]; }
  float nac0 = act[(size_t)t0 * 128 + lane], nac1 = act[(size_t)t0 * 128 + 64 + lane];
  P6_LOADV(A, sA, P6_ID(r));
  for (int t = t0; t < SEQ; t += tstride) {
    int lt = lane; asm volatile("" : "+v"(lt));
    const int tn = t + tstride < SEQ ? t + tstride : t;
    const int nid0 = pidx[(size_t)tn * 128 + lane], nid1 = pidx[(size_t)tn * 128 + 64 + lane];
    const float ac0 = nac0, ac1 = nac1; nac0 = act[(size_t)tn * 128 + lane]; nac1 = act[(size_t)tn * 128 + 64 + lane];
    f32x2 outp[16]; u32x4 xv[4];
#pragma unroll
    for (int j = 0; j < 16; ++j) outp[j] = f32x2{0.f, 0.f};
#pragma nounroll
    for (int h = 0; h < 8; ++h) {
      P6_LOADV(B, sB, P6_ID(h * 16 + 8 + r));
      P6_COMPV(A, sA, h * 16);
      if (h < 7) P6_LOADV(A, sA, P6_ID(h * 16 + 16 + r));
      else {
#pragma unroll
        for (int c = 0; c < 2; ++c)
#pragma unroll
          for (int q = 0; q < 2; ++q) xv[c * 2 + q] = *(const u32x4*)(xb + (size_t)t * DM + c * 1024 + lt * 16 + q * 8);
        asm volatile("" ::: "memory");
        P6_LOADV(A, sA, __builtin_amdgcn_readlane(nid0, r)); }
      P6_COMPV(B, sB, h * 16 + 8);
    }
    id0 = nid0; id1 = nid1;
    float xn[32]; float s2 = 0.f;
#pragma unroll
    for (int c = 0; c < 2; ++c)
#pragma unroll
      for (int q = 0; q < 2; ++q) { const u32x4 v = xv[c * 2 + q]; const unsigned vw[4] = {v.x, v.y, v.z, v.w};
#pragma unroll
        for (int j = 0; j < 4; ++j) { xn[c * 16 + q * 8 + 2 * j] = __uint_as_float(vw[j] << 16); xn[c * 16 + q * 8 + 2 * j + 1] = __uint_as_float(vw[j] & 0xffff0000u); } }
#pragma unroll
    for (int c = 0; c < 2; ++c)
#pragma unroll
      for (int j = 0; j < 16; ++j) { const int col = c * 1024 + lt * 16 + j; const float o_ = (j & 1) ? outp[c * 8 + (j >> 1)].y : outp[c * 8 + (j >> 1)].x; const float y = xn[c * 16 + j] + gtv[c * 16 + j] * o_; xn[c * 16 + j] = y; s2 += y * y; }
    s2 = wsum64(s2); const float r2 = rsqrtf(s2 * (1.0f / DM) + 1e-6f);
#pragma unroll
    for (int c = 0; c < 2; ++c)
#pragma unroll
      for (int q = 0; q < 4; ++q) { const int col = c * 1024 + lt * 16 + q * 4; float4 o; o.x = xn[c * 16 + q * 4] * r2 * fgv[c * 16 + q * 4]; o.y = xn[c * 16 + q * 4 + 1] * r2 * fgv[c * 16 + q * 4 + 1]; o.z = xn[c * 16 + q * 4 + 2] * r2 * fgv[c * 16 + q * 4 + 2]; o.w = xn[c * 16 + q * 4 + 3] * r2 * fgv[c * 16 + q * 4 + 3];
        *(float4*)(xio + (size_t)t * DM + col) = o; }
  }
#undef P6_ID
#undef P6_AC
#undef P6_LOADV
#undef P6_COMPV
}
}

namespace tk {
typedef short bf16x8 __attribute__((ext_vector_type(8)));
typedef float f32x16 __attribute__((ext_vector_type(16)));
typedef unsigned u32x4 __attribute__((ext_vector_type(4)));
typedef float f32x4 __attribute__((ext_vector_type(4)));
constexpr int OFF_SCR = 65536;
__device__ __forceinline__ float vmax(float a, float b) { float r; asm("v_max_f32 %0, %1, %2" : "=v"(r) : "v"(a), "v"(b)); return r; }
__device__ __forceinline__ float vmin(float a, float b) { float r; asm("v_min_f32 %0, %1, %2" : "=v"(r) : "v"(a), "v"(b)); return r; }
#define TK_CE(A, i, j) { const float hi_ = vmax(A[i], A[j]); A[j] = vmin(A[i], A[j]); A[i] = hi_; }
__device__ __forceinline__ void sort16(f32x16& a) { TK_CE(a, 0,1) TK_CE(a, 2,3) TK_CE(a, 0,2) TK_CE(a, 1,3) TK_CE(a, 1,2) TK_CE(a, 4,5) TK_CE(a, 6,7) TK_CE(a, 4,6) TK_CE(a, 5,7) TK_CE(a, 5,6) TK_CE(a, 0,4) TK_CE(a, 2,6) TK_CE(a, 2,4) TK_CE(a, 1,5) TK_CE(a, 3,7) TK_CE(a, 3,5) TK_CE(a, 1,2) TK_CE(a, 3,4) TK_CE(a, 5,6) TK_CE(a, 8,9) TK_CE(a, 10,11) TK_CE(a, 8,10) TK_CE(a, 9,11) TK_CE(a, 9,10) TK_CE(a, 12,13) TK_CE(a, 14,15) TK_CE(a, 12,14) TK_CE(a, 13,15) TK_CE(a, 13,14) TK_CE(a, 8,12) TK_CE(a, 10,14) TK_CE(a, 10,12) TK_CE(a, 9,13) TK_CE(a, 11,15) TK_CE(a, 11,13) TK_CE(a, 9,10) TK_CE(a, 11,12) TK_CE(a, 13,14) TK_CE(a, 0,8) TK_CE(a, 4,12) TK_CE(a, 4,8) TK_CE(a, 2,10) TK_CE(a, 6,14) TK_CE(a, 6,10) TK_CE(a, 2,4) TK_CE(a, 6,8) TK_CE(a, 10,12) TK_CE(a, 1,9) TK_CE(a, 5,13) TK_CE(a, 5,9) TK_CE(a, 3,11) TK_CE(a, 7,15) TK_CE(a, 7,11) TK_CE(a, 3,5) TK_CE(a, 7,9) TK_CE(a, 11,13) TK_CE(a, 1,2) TK_CE(a, 3,4) TK_CE(a, 5,6) TK_CE(a, 7,8) TK_CE(a, 9,10) TK_CE(a, 11,12) TK_CE(a, 13,14) }
__device__ __forceinline__ void bitonic16(f32x16& a) { TK_CE(a, 0,8) TK_CE(a, 1,9) TK_CE(a, 2,10) TK_CE(a, 3,11) TK_CE(a, 4,12) TK_CE(a, 5,13) TK_CE(a, 6,14) TK_CE(a, 7,15) TK_CE(a, 0,4) TK_CE(a, 1,5) TK_CE(a, 2,6) TK_CE(a, 3,7) TK_CE(a, 8,12) TK_CE(a, 9,13) TK_CE(a, 10,14) TK_CE(a, 11,15) TK_CE(a, 0,2) TK_CE(a, 1,3) TK_CE(a, 4,6) TK_CE(a, 5,7) TK_CE(a, 8,10) TK_CE(a, 9,11) TK_CE(a, 12,14) TK_CE(a, 13,15) TK_CE(a, 0,1) TK_CE(a, 2,3) TK_CE(a, 4,5) TK_CE(a, 6,7) TK_CE(a, 8,9) TK_CE(a, 10,11) TK_CE(a, 12,13) TK_CE(a, 14,15) }
__device__ __forceinline__ void merge16(f32x16& a, const f32x16& b) {
#pragma unroll
  for (int i = 0; i < 16; ++i) a[i] = vmax(a[i], b[15 - i]);
  bitonic16(a);
}
__device__ __forceinline__ float packf(float v, unsigned mask, unsigned code) { return __uint_as_float((__float_as_uint(v) & mask) | code); }

__device__ __forceinline__ void stage_subkeys(const float* __restrict__ sk, char* lds, int tid) {
  for (int e = tid; e < 2 * 128 * 16; e += 512) { const int row = e >> 4, ch = e & 15;
    const float4 a = *(const float4*)(sk + (size_t)row * 128 + ch * 8), b = *(const float4*)(sk + (size_t)row * 128 + ch * 8 + 4);
    u32x4 w = {pg8::cvt_pk_bf16(a.x, a.y), pg8::cvt_pk_bf16(a.z, a.w), pg8::cvt_pk_bf16(b.x, b.y), pg8::cvt_pk_bf16(b.z, b.w)};
    *(u32x4*)(lds + (row >> 7) * 32768 + AT_KSWZ(row & 127, ch * 16)) = w; }
}
__device__ __forceinline__ void topk_task(int tg, int h, const bf16_t* __restrict__ qp, char* lds, int wid, int lane, int* pidx, float* pgate) {
  const int r32 = lane & 31, hi = lane >> 5;
  f32x16 L[2];
#pragma unroll
  for (int p = 0; p < 2; ++p) {
    f32x16 acc[4] = {};
    const bf16_t* qrow = qp + (size_t)(tg * 32 + r32) * DM + h * 256 + p * 128 + hi * 8;
    const char* skb = lds + p * 32768;
#pragma unroll
    for (int ks = 0; ks < 8; ++ks) { const bf16x8 qf = *reinterpret_cast<const bf16x8*>(qrow + ks * 16); const int cb = (ks * 16 + hi * 8) * 2;
#pragma unroll
      for (int kb = 0; kb < 4; ++kb) { const bf16x8 af = *reinterpret_cast<const bf16x8*>(skb + AT_KSWZ(kb * 32 + r32, cb)); acc[kb] = __builtin_amdgcn_mfma_f32_32x32x16_bf16(af, qf, acc[kb], 0, 0, 0); } }
#pragma unroll
    for (int kb = 0; kb < 4; ++kb)
#pragma unroll
      for (int r = 0; r < 16; ++r) acc[kb][r] = packf(acc[kb][r], 0xFFFFFF80u, (unsigned)(kb * 32 + (r & 3) + 8 * (r >> 2) + 4 * hi));
    sort16(acc[0]); sort16(acc[1]); sort16(acc[2]); sort16(acc[3]);
    merge16(acc[0], acc[1]); merge16(acc[2], acc[3]); merge16(acc[0], acc[2]);
    f32x16 pr;
#pragma unroll
    for (int i = 0; i < 16; ++i) { auto rr = __builtin_amdgcn_permlane32_swap(__float_as_uint(acc[0][i]), __float_as_uint(acc[0][i]), false, false); pr[i] = __uint_as_float(hi ? rr[0] : rr[1]); }
    merge16(acc[0], pr);
    L[p] = acc[0];
  }
  unsigned* scr = (unsigned*)(lds + OFF_SCR + wid * 8192) + lane;
#pragma unroll
  for (int i = 0; i < 16; ++i) { scr[64 * i] = __float_as_uint(L[0][i]) & 127u; scr[64 * (16 + i)] = __float_as_uint(L[1][i]) & 127u; }
  const f32x16& a = L[0]; const f32x16& b = L[1];
  const float ninf = -__builtin_inff();
  f32x16 G1, G2, G3, G4;
#define TK_C(i, j) packf(a[i] + b[j], 0xFFFFFF00u, (unsigned)((i) << 4 | (j)))
#pragma unroll
  for (int j = 0; j < 16; ++j) G1[j] = TK_C(0, j);
#pragma unroll
  for (int j = 0; j < 8; ++j) { G2[j] = TK_C(1, j); G2[8 + j] = TK_C(15 - j, 0); }
  G3[0] = TK_C(2, 0); G3[1] = TK_C(2, 1); G3[2] = TK_C(2, 2); G3[3] = TK_C(2, 3); G3[4] = TK_C(2, 4); G3[5] = TK_C(3, 0); G3[6] = TK_C(3, 1); G3[7] = TK_C(3, 2); G3[8] = TK_C(3, 3);
  G3[9] = TK_C(4, 0); G3[10] = TK_C(4, 1); G3[11] = TK_C(4, 2); G3[12] = TK_C(5, 0); G3[13] = TK_C(5, 1); G3[14] = TK_C(6, 0); G3[15] = TK_C(6, 1);
  G4[0] = TK_C(7, 0); G4[1] = TK_C(7, 1);
#pragma unroll
  for (int j = 2; j < 16; ++j) G4[j] = ninf;
#undef TK_C
  bitonic16(G2); sort16(G3); TK_CE(G4, 0, 1);
  merge16(G1, G2); merge16(G3, G4); merge16(G1, G3);
  asm volatile("s_waitcnt lgkmcnt(0)" ::: "memory");
  float e[16]; float sum = 0.f; int idx[16];
#pragma unroll
  for (int i = 0; i < 16; ++i) { e[i] = __builtin_amdgcn_exp2f((G1[i] - G1[0]) * 1.4426950408889634f); sum += e[i];
    const unsigned code = __float_as_uint(G1[i]) & 255u; idx[i] = (int)(scr[64 * (code >> 4)] * 128u + scr[64 * (16 + (code & 15u))]); }
  const float rs = __builtin_amdgcn_rcpf(sum);
  const size_t o = ((size_t)(tg * 32 + r32) * 8 + h) * 16;
  if (hi == 0) {
#pragma unroll
    for (int q = 0; q < 4; ++q) *(int4*)(pidx + o + q * 4) = make_int4(idx[q * 4], idx[q * 4 + 1], idx[q * 4 + 2], idx[q * 4 + 3]);
  } else {
#pragma unroll
    for (int q = 0; q < 4; ++q) *(float4*)(pgate + o + q * 4) = make_float4(e[q * 4] * rs, e[q * 4 + 1] * rs, e[q * 4 + 2] * rs, e[q * 4 + 3] * rs);
  }
}
}

#define XB_TMO      128
#define XB_XCNT(j)  (256  + 64 * (j))
#define XB_XSUB(j)  (1280 + 64 * (j))
#define XB_XGEN(j)  (2304 + 64 * (j))
#define XB_TOP      3328
#define XB_TOPGEN   3392
#define XB_SPIN_CAP (1u << 20)
#define XB_LAS __attribute__((address_space(3)))
__device__ __forceinline__ unsigned xb_ld(unsigned* p)              { return __hip_atomic_load(p, __ATOMIC_RELAXED, __HIP_MEMORY_SCOPE_AGENT); }
__device__ __forceinline__ unsigned xb_add(unsigned* p, unsigned v) { return __hip_atomic_fetch_add(p, v, __ATOMIC_RELAXED, __HIP_MEMORY_SCOPE_AGENT); }
__device__ __forceinline__ unsigned xb_xcc_id() { return (unsigned)__builtin_amdgcn_s_getreg((3 << 11) | 20) & 0xFu; }
#define XB_SPIN(cond, bar) do { unsigned _sp = 0; while (cond) { __builtin_amdgcn_s_sleep(1); \
    if ((++_sp & 255u) == 0u) { if (xb_ld(&(bar)[XB_TMO])) break; if (_sp > XB_SPIN_CAP) { atomicAdd(&(bar)[XB_TMO], 1u); break; } } } } while (0)
struct XcdBarrier { unsigned* bar; unsigned x; volatile XB_LAS unsigned* st; };
__device__ __forceinline__ XcdBarrier xcd_barrier_post(unsigned* bar, volatile XB_LAS unsigned* st) {
    XcdBarrier b; b.bar = bar; b.x = xb_xcc_id(); b.st = st;
    if (threadIdx.x == 0) (void)xb_add(&bar[XB_XCNT(b.x)], 1u);
    return b;
}
__device__ __forceinline__ void xcd_barrier_complete(unsigned* bar, unsigned x, unsigned& nloc, unsigned& nx) {
    const unsigned G = gridDim.x * gridDim.y * gridDim.z;
    unsigned sum, cnt, mine, sp = 0u;
    for (;;) {
        sum = 0u; cnt = 0u; mine = 0u;
#pragma unroll
        for (unsigned j = 0; j < 16; ++j) { const unsigned c = xb_ld(&bar[XB_XCNT(j)]); sum += c; cnt += (c > 0u) ? 1u : 0u; mine = (j == x) ? c : mine; }
        if (sum == G) break;
        __builtin_amdgcn_s_sleep(1);
        if ((++sp & 255u) == 0u) { if (xb_ld(&bar[XB_TMO])) break; if (sp > XB_SPIN_CAP) { atomicAdd(&bar[XB_TMO], 1u); break; } }
    }
    nloc = mine > 0u ? mine : 1u; nx = cnt > 0u ? cnt : 1u;
}
__device__ __forceinline__ void xcd_barrier(const XcdBarrier& b) {
    asm volatile("s_waitcnt vmcnt(0)" ::: "memory");
    __syncthreads();
    if (threadIdx.x == 0) {
        unsigned* bar = b.bar;
        __builtin_amdgcn_s_waitcnt(0);
        unsigned nloc = b.st[0], nx = b.st[1];
        if (nloc == 0u) { xcd_barrier_complete(bar, b.x, nloc, nx); b.st[0] = nloc; b.st[1] = nx; }
        const unsigned old = xb_add(&bar[XB_XSUB(b.x)], 1u);
        const unsigned gen = old / nloc;
        if (old + 1u == (gen + 1u) * nloc) {
            __builtin_amdgcn_fence(__ATOMIC_RELEASE, "agent");
            asm volatile("s_waitcnt vmcnt(0)" ::: "memory");
            const unsigned og = xb_add(&bar[XB_TOP], 1u);
            const unsigned tg = og / nx;
            if (og + 1u == (tg + 1u) * nx) xb_add(&bar[XB_TOPGEN], 1u);
            else XB_SPIN(xb_ld(&bar[XB_TOPGEN]) == tg, bar);
            __builtin_amdgcn_fence(__ATOMIC_ACQUIRE, "agent");
            xb_add(&bar[XB_XGEN(b.x)], 1u);
            asm volatile("s_waitcnt vmcnt(0)" ::: "memory");
        } else {
            XB_SPIN(xb_ld(&bar[XB_XGEN(b.x)]) == gen, bar);
            __builtin_amdgcn_fence(__ATOMIC_ACQUIRE, "agent");
            asm volatile("s_waitcnt vmcnt(0)" ::: "memory");
        }
    }
    __syncthreads();
}

__device__ __forceinline__ void p0_ada_partial(int b, char* lds, const float* __restrict__ c, const float* __restrict__ cctx, const float* __restrict__ wmod, float* part) {
  int tid = threadIdx.x; asm volatile("" : "+v"(tid));
  float* sl = (float*)lds;
  const int slab = b >> 3, chunk = b & 7, k0 = slab * 64;
  __syncthreads();
  if (tid < 128) { const int cond = tid >> 6, k = tid & 63; const float x = (cond ? cctx : c)[k0 + k]; sl[tid] = x / (1.0f + expf(-x)); }
  __syncthreads();
  if (tid < 384) {
    const int col = chunk * 1536 + tid * 4; float4 a0 = {0.f, 0.f, 0.f, 0.f}, a1 = a0;
    const float* wp = wmod + (size_t)k0 * NMOD + col;
#pragma unroll 8
    for (int k = 0; k < 64; ++k) { const float4 w = *(const float4*)(wp + (size_t)k * NMOD); const float s0 = sl[k], s1 = sl[64 + k];
      a0.x += s0 * w.x; a0.y += s0 * w.y; a0.z += s0 * w.z; a0.w += s0 * w.w; a1.x += s1 * w.x; a1.y += s1 * w.y; a1.z += s1 * w.z; a1.w += s1 * w.w; }
    *(float4*)(part + ((size_t)slab * 2 + 0) * NMOD + col) = a0; *(float4*)(part + ((size_t)slab * 2 + 1) * NMOD + col) = a1;
  }
}
__device__ __forceinline__ void p1_modulate(int b, int nb, char* lds, const float* __restrict__ part, const float* __restrict__ bmod, const float* __restrict__ g1, const float* __restrict__ x, const float* __restrict__ ctx,
                                            float* mod, bf16_t* hx) {
  int tid = threadIdx.x; asm volatile("" : "+v"(tid));
  const int wid = tid >> 6, lane = tid & 63;
  float* vA = (float*)lds;
  float* vB = vA + 2 * DM;
  __syncthreads();
  const int ncond = (b < 32) ? 2 : 1;
  for (int e = tid; e < ncond * DM; e += 512) { const int cond = e >> 11, col = e & (DM - 1); float sh = bmod[col], sc = bmod[DM + col];
    for (int s = 0; s < 32; ++s) { sh += part[((size_t)s * 2 + cond) * NMOD + col]; sc += part[((size_t)s * 2 + cond) * NMOD + DM + col]; }
    vA[cond * DM + col] = g1[col] * (1.0f + sc); vB[cond * DM + col] = sh; }
  if (tid < 96) { const int cond = tid / 48; for (int col = b * 48 + tid % 48; col < NMOD; col += nb * 48) { float v = bmod[col];
      for (int s = 0; s < 32; ++s) v += part[((size_t)s * 2 + cond) * NMOD + col];
      mod[cond * NMOD + col] = v; } }
  __syncthreads();
  for (int r = b * 8 + wid; r < TOT; r += nb * 8) {
    const bool isx = r < SEQ; const float* xr = isx ? x + (size_t)r * DM : ctx + (size_t)(r - SEQ) * DM; const float* a = vA + (isx ? 0 : DM); const float* bb = vB + (isx ? 0 : DM);
    float v[32]; float ss = 0.f;
#pragma unroll
    for (int q = 0; q < 8; ++q) { const float4 t = *(const float4*)(xr + q * 256 + lane * 4); v[q * 4] = t.x; v[q * 4 + 1] = t.y; v[q * 4 + 2] = t.z; v[q * 4 + 3] = t.w; ss += t.x * t.x + t.y * t.y + t.z * t.z + t.w * t.w; }
    ss = wave_sum(ss); const float rinv = rsqrtf(ss * (1.0f / DM) + 1e-6f);
#pragma unroll
    for (int q = 0; q < 8; ++q) { const int c0 = q * 256 + lane * 4; const float4 av = *(const float4*)(a + c0), bv = *(const float4*)(bb + c0);
      int o = 0; o = __builtin_amdgcn_cvt_pk_fp8_f32(v[q * 4] * rinv * av.x + bv.x, v[q * 4 + 1] * rinv * av.y + bv.y, o, false); o = __builtin_amdgcn_cvt_pk_fp8_f32(v[q * 4 + 2] * rinv * av.z + bv.z, v[q * 4 + 3] * rinv * av.w + bv.w, o, true);
      *(int*)((unsigned char*)hx + (size_t)r * DM + c0) = o; }
  }
}
__device__ __forceinline__ void p0_small(int b, const float* lq1, const float* lk1, const float* lq2, const float* lk2, float* misc, float* rope, float* rcos, float* rsin) {
  int tid = threadIdx.x; asm volatile("" : "+v"(tid));
  if (b == 0 && tid == 0) { float a = 0.f, c = 0.f; for (int i = 0; i < 64; ++i) { a += lq1[i] * lk1[i]; c += lq2[i] * lk2[i]; } misc[0] = expf(a) - expf(c) + 0.2f; }
  if (b == 1) { for (int e = tid; e < 256 * 16; e += 512) { const int pos = e >> 4, i = e & 15; const float fr = powf(10000.0f, -(float)i / 16.0f); const float ang = (float)pos * fr;
      const float cs = cosf(ang), sn = sinf(ang); rope[e * 2] = cs; rope[e * 2 + 1] = sn; rcos[e] = cs; rsin[e] = sn; } }
}

#include <hip/hip_cooperative_groups.h>
namespace cg = cooperative_groups;

struct Params {
  const float *x, *c, *ctx, *cctx, *wmod, *bmod, *g1, *g2, *win, *lq1, *lk1, *lq2, *lk2, *subln, *rpb, *wa, *wb, *wo, *wq, *subkeys, *U, *V, *fg;
  float* out; WS w;
};

constexpr int MEGA_LDS = 163840;

__global__ __launch_bounds__(512, 2) void mega(Params p) {
  extern __shared__ __attribute__((aligned(16))) char smem[];
  cg::grid_group grid = cg::this_grid();
#define HALF_TID int t_ = threadIdx.x; asm volatile("" : "+v"(t_)); const int half = t_ >> 8, tid = t_ & 255; char* lds = smem + half * 32768; (void)lds; (void)tid;
  const int nb = gridDim.x; const WS& w = p.w;
  volatile XB_LAS unsigned* xst = (volatile XB_LAS unsigned*)(smem + MEGA_LDS - 16);
  if (threadIdx.x == 0) { xst[0] = 0u; xst[1] = 0u; }
  __syncthreads();
  const XcdBarrier xb = xcd_barrier_post(w.bar, xst);
  if (w.bar == nullptr) grid.sync();
  const float* modc = w.mod; const float* modx = w.mod + NMOD;
#define VLOOP(NB) for (int vb = blockIdx.x * 2 + half; vb < (NB); vb += nb * 2)
  PG8_LAS unsigned char* glds = (PG8_LAS unsigned char*)smem;
  for (int b2 = blockIdx.x; b2 < 256; b2 += nb) p0_ada_partial(b2, smem, p.c, p.cctx, p.wmod, w.part);
  p0_small(blockIdx.x, p.lq1, p.lk1, p.lq2, p.lk2, w.misc, w.rope, w.rcos, w.rsin);
  for (int i = blockIdx.x * 512 + threadIdx.x; i < SEQ + 2048; i += nb * 512) w.rowss[i] = 0ull;
  for (int tile = blockIdx.x; tile < 2560; tile += nb) prep_transpose8(tile, smem, p.win, NIN, DM, NIN, (unsigned char*)w.wt_in, DM, 0);
  xcd_barrier(xb);
  p1_modulate(blockIdx.x, nb, smem, w.part, p.bmod, p.g1, p.x, p.ctx, w.mod, w.hx);
  xcd_barrier(xb);
  const bool prep_first = blockIdx.x >= 16 && nb > 16 && ((blockIdx.x >> 3) & 1);
#pragma nounroll
  for (int pass = 0; pass < 2; ++pass) {
    if ((pass == 0) != prep_first) {
      if ((blockIdx.x >> 4) & 1) { __builtin_amdgcn_s_sleep(127); __builtin_amdgcn_s_sleep(127); }
      { pg8::EpiInProj8 e; e.w = w; e.rcos = w.rcos; e.rsin = w.rsin; pg8::InProjOrder S; S.init(nb, blockIdx.x);
        pg8::Gemm g; g.A = w.hx; g.Bt = w.wt_in; g.M = TOT; g.N = NIN; g.K = DM; pg8::gemm_phase8(glds, g, S, e); }
    } else {
      __syncthreads();
      if (blockIdx.x >= 16 || nb <= 16) { const int b3 = nb > 16 ? (int)blockIdx.x - 16 : (int)blockIdx.x, n3 = nb > 16 ? nb - 16 : nb;
        for (int tile = 2560 + b3; tile < 4096; tile += n3) {
          if (tile < 2816) prep_transpose8(tile - 2560, smem, p.wa, DM, 1024, DM, (unsigned char*)w.wt_ab, DM, 0);
          else if (tile < 3072) prep_transpose8(tile - 2816, smem, p.wb, DM, 1024, DM, (unsigned char*)w.wt_ab, DM, 1024);
          else if (tile < 3584) prep_transpose8(tile - 3072, smem, p.wo, DM, DM, DM, (unsigned char*)w.wt_o, DM, 0);
          else prep_transpose(tile - 3584, smem, p.wq, DM, DM, DM, w.wt_q, DM, 0, p.g2, modc + 4 * DM, modc + 3 * DM, w.bq);
        }
        int t2 = threadIdx.x; asm volatile("" : "+v"(t2)); const int wv = t2 >> 6, ln = t2 & 63;
        float fv[32], hv[32];
    #pragma unroll
        for (int q = 0; q < 8; ++q) { const float4 g4 = *(const float4*)(p.g2 + ln * 32 + q * 4), s4 = *(const float4*)(modc + 4 * DM + ln * 32 + q * 4), h4 = *(const float4*)(modc + 3 * DM + ln * 32 + q * 4);
          fv[q * 4] = g4.x * (1.0f + s4.x); fv[q * 4 + 1] = g4.y * (1.0f + s4.y); fv[q * 4 + 2] = g4.z * (1.0f + s4.z); fv[q * 4 + 3] = g4.w * (1.0f + s4.w); hv[q * 4] = h4.x; hv[q * 4 + 1] = h4.y; hv[q * 4 + 2] = h4.z; hv[q * 4 + 3] = h4.w; }
        for (int row = b3 * 8 + wv; row < 16384; row += n3 * 8) {
          float va[32], vb[32]; p6::quant_load_nat(p.U + (size_t)row * DM, va, ln); p6::quant_load(p.V + (size_t)row * DM, vb, ln);
          { float cs_ = 0.f;
    #pragma unroll
            for (int j = 0; j < 32; ++j) { cs_ += va[j] * hv[j]; va[j] *= fv[j]; }
            cs_ = wave_sum(cs_); if (ln == 0) w.uscale[2 * row + 1] = cs_; }
          p6::quant_fin4(va, w.u8 + (size_t)row * 1024, w.uscale + 2 * row, ln); p6::quant_fin4b(vb, w.v8 + (size_t)row * 1024, w.v8 + (size_t)16384 * 1024 + (size_t)row * 64, ln); } }
      __syncthreads();
    }
  }
  xcd_barrier(xb);
  { const float lam = w.misc[0]; const int hh = blockIdx.x & 7, sub = blockIdx.x >> 3, nsub = nb >> 3;
    for (int qb = sub; qb < 64; qb += nsub) da::diff_attn_item(hh, qb, w.qa, w.ka, w.va, p.subln, lam, w.kmax, w.outa, smem);
    for (int rb = sub; rb < 64; rb += nsub) da::na_item8(hh, rb, w.qb, w.kb, w.vb, p.rpb, (bf16_t*)((unsigned char*)w.outa + 1024), smem); }
  xcd_barrier(xb);
  if ((blockIdx.x >> 3) & 1) __builtin_amdgcn_s_sleep(127);
  { pg8::EpiMerge8 e; e.sga = (const unsigned char*)w.sga; e.sgb = (const unsigned char*)w.sgb; e.out = (unsigned char*)w.mrg; pg8::StaticOrder S; S.init(SEQ, DM, nb, blockIdx.x);
    pg8::Gemm g; g.A = w.outa; g.Bt = w.wt_ab; g.M = SEQ; g.N = DM; g.K = DM; pg8::gemm_phase8(glds, g, S, e); }
  xcd_barrier(xb);
  if ((blockIdx.x >> 3) & 1) __builtin_amdgcn_s_sleep(127);
  { pg8::EpiResidB8 e; e.x = p.x; e.gt = modc + 2 * DM; e.out = w.outa; e.sc = 1.0f / 512.0f; e.rowss = w.rowss; e.out8 = (unsigned char*)w.sgb; pg8::StaticOrder S; S.init(SEQ, DM, nb, blockIdx.x);
    pg8::Gemm g; g.A = w.mrg; g.Bt = w.wt_o; g.M = SEQ; g.N = DM; g.K = DM; pg8::gemm_phase8(glds, g, S, e); }
  xcd_barrier(xb);
  if ((blockIdx.x >> 3) & 1) __builtin_amdgcn_s_sleep(127);
  { pg8::EpiQ e; e.out = w.sga; e.ld = DM; e.rowss = w.rowss; e.bq = w.bq; e.rinv = w.rinv; pg8::StaticOrder S; S.init(SEQ, DM, nb, blockIdx.x);
    pg8::Gemm g; g.A = w.outa; g.Bt = w.wt_q; g.M = SEQ; g.N = DM; g.K = DM; pg8::gemm_phase(glds, g, S, e); }
  xcd_barrier(xb);
  int xrank = 0;
  { int t2 = threadIdx.x; asm volatile("" : "+v"(t2)); const int wv = __builtin_amdgcn_readfirstlane(t2 >> 6), ln = t2 & 63; const int hh = blockIdx.x & 7, sub = blockIdx.x >> 3;
    __syncthreads(); tk::stage_subkeys(p.subkeys + (size_t)hh * 32768, smem, t2); __syncthreads();
    if (t2 == 0) xrank = (int)atomicAdd(w.kmax + 32 + (xb.x & 7), 1u);
    for (int tg = sub * 8 + wv; tg < SEQ / 32; tg += (nb >> 3) * 8) tk::topk_task(tg, hh, w.sga, smem, wv, ln, w.pidx, w.pgate); }
  xcd_barrier(xb);
  { int t2 = threadIdx.x; asm volatile("" : "+v"(t2)); const int wv = __builtin_amdgcn_readfirstlane(t2 >> 6), ln = t2 & 63;
    float* actb = (float*)w.mrg;
    __syncthreads(); if (t2 == 0) { bool even_ = true; for (int x_ = 0; x_ < 8; ++x_) even_ = even_ && (__hip_atomic_load(w.kmax + 32 + x_, __ATOMIC_RELAXED, __HIP_MEMORY_SCOPE_AGENT) == (unsigned)(nb >> 3));
      ((volatile int*)smem)[8192] = even_ ? (int)(xb.x & 7) : (int)(blockIdx.x & 7); ((volatile int*)smem)[8193] = even_ ? xrank : (int)(blockIdx.x >> 3); }
    __syncthreads(); const int sl_ = ((volatile int*)smem)[8192], rk_ = ((volatile int*)smem)[8193]; __syncthreads();
    p6::expert_u_slice(sl_, rk_ * 8 + wv, (nb >> 3) * 8, ln, smem + wv * 4096, (const unsigned char*)w.sgb, w.pidx, w.pgate, w.u8, w.uscale, actb, w.rinv);
    xcd_barrier(xb);
    p6::expert_v_tokens(blockIdx.x * 8 + wv, nb * 8, ln, p.out, w.outa, modc, w.pidx, actb, w.v8, p.fg); }
#undef VLOOP
}

extern "C" void kernel_launch(void* const* d_in, const int* in_sizes, int n_in, void* d_out, int out_size, void* d_ws, size_t ws_size, hipStream_t stream) {
  Params p{};
  const float** f = (const float**)&p.x;
  for (int i = 0; i < 23; ++i) f[i] = (const float*)d_in[i];
  p.out = (float*)d_out; p.w = make_ws(d_ws);
  static int grid_blocks = 0;
  if (!grid_blocks) {
    int dev = 0, cus = 0, per_cu = 0;
    hipGetDevice(&dev); hipDeviceGetAttribute(&cus, hipDeviceAttributeMultiprocessorCount, dev);
    if (hipFuncSetAttribute((const void*)mega, hipFuncAttributeMaxDynamicSharedMemorySize, MEGA_LDS) != hipSuccess) fprintf(stderr, "hipFuncSetAttribute failed\n");
    hipOccupancyMaxActiveBlocksPerMultiprocessor(&per_cu, mega, 512, MEGA_LDS);
    if (per_cu < 1) fprintf(stderr, "occupancy query returned %d\n", per_cu);
    grid_blocks = cus * (per_cu >= 1 ? 1 : 0);
    if (ws_size < (size_t)620 * 1024 * 1024) fprintf(stderr, "ws_size small: %zu\n", ws_size);
  }
  hipMemsetAsync(p.w.bar, 0, (XCD_BAR_WORDS + 64) * 4, stream);
  void* args[] = {&p};
  hipError_t e = hipLaunchCooperativeKernel((const void*)mega, dim3(grid_blocks), dim3(512), args, MEGA_LDS, stream);
  if (e != hipSuccess) fprintf(stderr, "cooperative launch failed: %s (grid %d)\n", hipGetErrorString(e), grid_blocks);
}
```
